# Optimizing an MI355X kernel written in HIP

```python
import jax
import jax.numpy as jnp
from jax import lax
import numpy as np

D_MODEL = 1024
BATCH = 16
SEQ = 2048
DEPTH = 4

HEAD_DIM = 64
BRANCH_W = 384
N_BRANCHES = 3
RWKV_HEADS = BRANCH_W // HEAD_DIM
RWKV_W = RWKV_HEADS * HEAD_DIM
DECAY_LORA = 64
AAA_LORA = 64
GATE_LORA = 160
RWKV_GN_EPS = 64e-5
SB_HEADS = BRANCH_W // HEAD_DIM
SB_W = SB_HEADS * HEAD_DIM
MLA_HEADS = 6
MLA_Q_LORA = 256
MLA_KV_LORA = 128
MLA_NOPE_DIM = 64
MLA_ROPE_DIM = 32
MLA_V_DIM = 64
MLA_W = MLA_HEADS * MLA_V_DIM
ROPE_THETA = 10000.0
MAX_POS_OFFSET = 1024
D_FF = 2816
MACARON_WEIGHT = 0.5
Q_BLOCK = 128
NORM_EPS = 1e-6
N_ADA = 9
RWKV_COLS = 3 * RWKV_W + DECAY_LORA + AAA_LORA + GATE_LORA
REST_SPLITS = (SB_W, SB_W, SB_W, MLA_Q_LORA, MLA_KV_LORA, MLA_ROPE_DIM, N_BRANCHES * D_MODEL)
D_IN = RWKV_COLS + 3 * SB_W + MLA_Q_LORA + MLA_KV_LORA + MLA_ROPE_DIM + N_BRANCHES * D_MODEL

kernel_name = 'hybrid_rwkv7_stickbreak_mla_macaron_adaln'


def _rms_norm(x, g):
    xf = x.astype(jnp.float32)
    y = xf * lax.rsqrt(jnp.mean(xf * xf, axis=-1, keepdims=True) + NORM_EPS)
    return (y * g.astype(jnp.float32)).astype(x.dtype)


def _modulated_norm(x, g, shift, scale):
    return _rms_norm(x, g) * (1.0 + scale[:, None, :]) + shift[:, None, :]


def _swiglu(h, w_in, w_out):
    gate, up = jnp.split(h @ w_in, 2, axis=-1)
    return (jax.nn.silu(gate) * up) @ w_out


def _split(p, sizes):
    out, off = [], 0
    for s in sizes:
        out.append(p[..., off:off + s])
        off += s
    return out


def _heads(t, n_heads):
    b, s, _ = t.shape
    return t.reshape(b, s, n_heads, -1)


def _token_shift(p, mu):
    prev = jnp.pad(p, ((0, 0), (1, 0), (0, 0)))[:, :-1]
    return p + (prev - p) * mu


def _wkv7_scan(r, w, k, v, a, b):
    bsz, _, n_heads, n = r.shape

    def step(state, inp):
        r_t, w_t, k_t, v_t, a_t, b_t = inp
        sa = jnp.einsum('bhvk,bhk->bhv', state, a_t)
        state = (state * w_t[:, :, None, :] + sa[..., None] * b_t[:, :, None, :]
                 + v_t[..., None] * k_t[:, :, None, :])
        return state, jnp.einsum('bhvk,bhk->bhv', state, r_t)

    xs = tuple(jnp.swapaxes(t, 0, 1) for t in (r, w, k, v, a, b))
    state0 = jnp.zeros((bsz, n_heads, n, n), jnp.float32)
    _, ys = lax.scan(step, state0, xs)
    return jnp.swapaxes(ys, 0, 1)


def _rwkv7_branch(r, k, v, dw, da, dg, w0, w2, a0, a2, g2, k_k, k_a, r_k, lnx_g, lnx_b):
    out_dtype = r.dtype
    f32 = jnp.float32
    r, k, v, dw, da, dg = (t.astype(f32) for t in (r, k, v, dw, da, dg))
    bsz, seq, _ = r.shape
    w_log = -jax.nn.softplus(-(w0 + jnp.tanh(dw) @ w2)) - 0.5
    decay = jnp.exp(-jnp.exp(w_log))
    a = jax.nn.sigmoid(a0 + da @ a2)
    g = jax.nn.sigmoid(dg) @ g2
    kk = _heads(k * k_k, RWKV_HEADS)
    kk = kk * lax.rsqrt(jnp.maximum(jnp.sum(kk * kk, axis=-1, keepdims=True), 1e-24))
    k = k * (1.0 + (a - 1.0) * k_a)
    rh, kh, vh, ah, wh = (_heads(t, RWKV_HEADS) for t in (r, k, v, a, decay))
    y = _wkv7_scan(rh, wh, kh, vh, -kk, kk * ah)
    mean = jnp.mean(y, axis=-1, keepdims=True)
    var = jnp.mean(jnp.square(y - mean), axis=-1, keepdims=True)
    y = ((y - mean) * lax.rsqrt(var + RWKV_GN_EPS)).reshape(bsz, seq, RWKV_W) * lnx_g + lnx_b
    bonus = jnp.sum(rh * kh * r_k, axis=-1, keepdims=True) * vh
    y = (y + bonus.reshape(bsz, seq, RWKV_W)) * g
    return y.astype(out_dtype)


def _stick_breaking_branch(q, k, v):
    bsz, seq, _ = q.shape
    q, k, v = (_heads(t, SB_HEADS) for t in (q, k, v))
    scale = HEAD_DIM ** -0.5
    outs = []
    for start in range(0, seq, Q_BLOCK):
        end = min(start + Q_BLOCK, seq)
        kp, vp = k[:, :end], v[:, :end]
        z = jnp.einsum('bqhd,bkhd->bhqk', q[:, start:end], kp).astype(jnp.float32) * scale
        t_idx = jnp.arange(start, end)
        s_idx = jnp.arange(end)
        mask = s_idx[None, :] < t_idx[:, None]
        log_1m = jnp.where(mask, jax.nn.log_sigmoid(-z), 0.0)
        rev = lax.cumsum(log_1m, axis=3, reverse=True)
        after = jnp.concatenate([rev[..., 1:], jnp.zeros_like(rev[..., :1])], axis=-1)
        weights = jnp.where(mask, jnp.exp(jax.nn.log_sigmoid(z) + after), 0.0)
        outs.append(jnp.einsum('bhqk,bkhd->bqhd', weights.astype(vp.dtype), vp))
    return jnp.concatenate(outs, axis=1).reshape(bsz, seq, SB_W)


def _rope_cos_sin(positions):
    inv_freq = 1.0 / (ROPE_THETA ** (jnp.arange(0, MLA_ROPE_DIM, 2, dtype=jnp.float32) / MLA_ROPE_DIM))
    ang = positions.astype(jnp.float32)[..., None] * inv_freq
    return jnp.cos(ang)[:, :, None, :], jnp.sin(ang)[:, :, None, :]


def _apply_rope(x, cos, sin):
    xf = x.astype(jnp.float32)
    half = MLA_ROPE_DIM // 2
    x1, x2 = xf[..., :half], xf[..., half:]
    return jnp.concatenate([x1 * cos - x2 * sin, x2 * cos + x1 * sin], axis=-1).astype(x.dtype)


def _mla_branch(cq, ckv, krope, positions, q_norm_g, w_uq, kv_norm_g, w_ukv):
    bsz, seq, _ = cq.shape
    q = (_rms_norm(cq, q_norm_g) @ w_uq).reshape(bsz, seq, MLA_HEADS, MLA_NOPE_DIM + MLA_ROPE_DIM)
    kv = (_rms_norm(ckv, kv_norm_g) @ w_ukv).reshape(bsz, seq, MLA_HEADS, MLA_NOPE_DIM + MLA_V_DIM)
    cos, sin = _rope_cos_sin(positions)
    q_nope = q[..., :MLA_NOPE_DIM]
    q_rope = _apply_rope(q[..., MLA_NOPE_DIM:], cos, sin)
    k_nope, v = kv[..., :MLA_NOPE_DIM], kv[..., MLA_NOPE_DIM:]
    k_rope = _apply_rope(krope[:, :, None, :], cos, sin)[:, :, 0]
    scale = (MLA_NOPE_DIM + MLA_ROPE_DIM) ** -0.5
    outs = []
    for start in range(0, seq, Q_BLOCK):
        end = min(start + Q_BLOCK, seq)
        s = (jnp.einsum('bqhd,bkhd->bhqk', q_nope[:, start:end], k_nope[:, :end])
             + jnp.einsum('bqhr,bkr->bhqk', q_rope[:, start:end], k_rope[:, :end])).astype(jnp.float32) * scale
        mask = jnp.arange(end)[None, :] <= jnp.arange(start, end)[:, None]
        probs = jax.nn.softmax(jnp.where(mask, s, -jnp.inf), axis=-1)
        outs.append(jnp.einsum('bhqk,bkhd->bqhd', probs.astype(v.dtype), v[:, :end]))
    return jnp.concatenate(outs, axis=1).reshape(bsz, seq, MLA_W)


def _token_mixer(h, positions, w_in, mu, w0, w2, a0, a2, g2, k_k, k_a, r_k, lnx_g, lnx_b,
                 q_norm_g, w_uq, kv_norm_g, w_ukv, branch_w, w_out):
    bsz, seq, _ = h.shape
    p = h @ w_in
    p_rwkv = _token_shift(p[..., :RWKV_COLS], mu)
    r, k, v, dw, da, dg = _split(p_rwkv, (RWKV_W, RWKV_W, RWKV_W, DECAY_LORA, AAA_LORA, GATE_LORA))
    sb_q, sb_k, sb_v, cq, ckv, krope, gate_logits = _split(p[..., RWKV_COLS:], REST_SPLITS)
    y_a = _rwkv7_branch(r, k, v, dw, da, dg, w0, w2, a0, a2, g2, k_k, k_a, r_k, lnx_g, lnx_b)
    y_b = _stick_breaking_branch(sb_q, sb_k, sb_v)
    y_c = _mla_branch(cq, ckv, krope, positions, q_norm_g, w_uq, kv_norm_g, w_ukv)
    ys = jnp.stack([y_a, y_b, y_c], axis=2)
    proj = jnp.einsum('bsnw,nwd->bsnd', ys, branch_w)
    gates = jax.nn.sigmoid(gate_logits.reshape(bsz, seq, N_BRANCHES, D_MODEL))
    merged = jnp.sum(gates * proj, axis=2)
    return merged @ w_out


def setup_inputs(seed: int = 0) -> dict:
    key = jax.random.key(seed)
    ks = jax.random.split(key, 32)
    f32 = jnp.float32

    def nrm(k, shape, fan_in, gain=1.0):
        return jax.random.normal(k, shape, f32) * (gain * fan_in ** -0.5)

    def noisy(k, shape, center, std):
        return center + std * jax.random.normal(k, shape, f32)

    x = jax.random.normal(ks[0], (BATCH, SEQ, D_MODEL), f32)
    c = jax.random.normal(ks[1], (BATCH, D_MODEL), f32)
    positions = (jnp.arange(SEQ, dtype=jnp.int32)[None, :]
                 + jax.random.randint(ks[2], (BATCH, 1), 0, MAX_POS_OFFSET, dtype=jnp.int32))
    return {
        'x': x,
        'c': c,
        'positions': positions,
        'ada_w': nrm(ks[3], (DEPTH, D_MODEL, N_ADA * D_MODEL), D_MODEL, 0.5),
        'ada_b': noisy(ks[4], (DEPTH, N_ADA * D_MODEL), 0.0, 0.01),
        'norm_g': noisy(ks[5], (DEPTH, 3, D_MODEL), 1.0, 0.05),
        'ffn1_w_in': nrm(ks[6], (DEPTH, D_MODEL, 2 * D_FF), D_MODEL),
        'ffn1_w_out': nrm(ks[7], (DEPTH, D_FF, D_MODEL), D_FF),
        'mix_w_in': nrm(ks[8], (DEPTH, D_MODEL, D_IN), D_MODEL),
        'rwkv_mu': jax.random.uniform(ks[9], (DEPTH, RWKV_COLS), f32),
        'rwkv_w0': jax.random.uniform(ks[10], (DEPTH, RWKV_W), f32, -6.0, 1.0),
        'rwkv_w2': nrm(ks[11], (DEPTH, DECAY_LORA, RWKV_W), DECAY_LORA),
        'rwkv_a0': noisy(ks[12], (DEPTH, RWKV_W), 0.0, 0.5),
        'rwkv_a2': nrm(ks[13], (DEPTH, AAA_LORA, RWKV_W), AAA_LORA),
        'rwkv_g2': nrm(ks[14], (DEPTH, GATE_LORA, RWKV_W), GATE_LORA),
        'rwkv_k_k': noisy(ks[15], (DEPTH, RWKV_W), 0.85, 0.05),
        'rwkv_k_a': noisy(ks[16], (DEPTH, RWKV_W), 1.0, 0.05),
        'rwkv_r_k': noisy(ks[17], (DEPTH, RWKV_HEADS, HEAD_DIM), 0.0, 0.1),
        'rwkv_lnx_g': noisy(ks[18], (DEPTH, RWKV_W), 1.0, 0.05),
        'rwkv_lnx_b': noisy(ks[19], (DEPTH, RWKV_W), 0.0, 0.01),
        'mla_q_norm_g': noisy(ks[20], (DEPTH, MLA_Q_LORA), 1.0, 0.05),
        'mla_w_uq': nrm(ks[21], (DEPTH, MLA_Q_LORA, MLA_HEADS * (MLA_NOPE_DIM + MLA_ROPE_DIM)), MLA_Q_LORA),
        'mla_kv_norm_g': noisy(ks[22], (DEPTH, MLA_KV_LORA), 1.0, 0.05),
        'mla_w_ukv': nrm(ks[23], (DEPTH, MLA_KV_LORA, MLA_HEADS * (MLA_NOPE_DIM + MLA_V_DIM)), MLA_KV_LORA),
        'branch_w': nrm(ks[24], (DEPTH, N_BRANCHES, BRANCH_W, D_MODEL), BRANCH_W),
        'mix_w_out': nrm(ks[25], (DEPTH, D_MODEL, D_MODEL), D_MODEL),
        'ffn2_w_in': nrm(ks[26], (DEPTH, D_MODEL, 2 * D_FF), D_MODEL),
        'ffn2_w_out': nrm(ks[27], (DEPTH, D_FF, D_MODEL), D_FF),
        'final_norm_g': noisy(ks[28], (D_MODEL,), 1.0, 0.05),
    }


def reference(x, c, positions, ada_w, ada_b, norm_g, ffn1_w_in, ffn1_w_out, mix_w_in,
              rwkv_mu, rwkv_w0, rwkv_w2, rwkv_a0, rwkv_a2, rwkv_g2, rwkv_k_k, rwkv_k_a,
              rwkv_r_k, rwkv_lnx_g, rwkv_lnx_b, mla_q_norm_g, mla_w_uq, mla_kv_norm_g,
              mla_w_ukv, branch_w, mix_w_out, ffn2_w_in, ffn2_w_out, final_norm_g):
    bsz = x.shape[0]
    c_act = jax.nn.silu(c)
    for l in range(DEPTH):
        mod = (c_act @ ada_w[l] + ada_b[l]).reshape(bsz, 3, 3, D_MODEL)
        h = _modulated_norm(x, norm_g[l, 0], mod[:, 0, 0], mod[:, 0, 1])
        x = x + MACARON_WEIGHT * mod[:, 0, 2][:, None, :] * _swiglu(h, ffn1_w_in[l], ffn1_w_out[l])
        h = _modulated_norm(x, norm_g[l, 1], mod[:, 1, 0], mod[:, 1, 1])
        mix = _token_mixer(h, positions, mix_w_in[l], rwkv_mu[l], rwkv_w0[l], rwkv_w2[l],
                           rwkv_a0[l], rwkv_a2[l], rwkv_g2[l], rwkv_k_k[l], rwkv_k_a[l],
                           rwkv_r_k[l], rwkv_lnx_g[l], rwkv_lnx_b[l], mla_q_norm_g[l],
                           mla_w_uq[l], mla_kv_norm_g[l], mla_w_ukv[l], branch_w[l], mix_w_out[l])
        x = x + mod[:, 1, 2][:, None, :] * mix
        h = _modulated_norm(x, norm_g[l, 2], mod[:, 2, 0], mod[:, 2, 1])
        x = x + MACARON_WEIGHT * mod[:, 2, 2][:, None, :] * _swiglu(h, ffn2_w_in[l], ffn2_w_out[l])
    return _rms_norm(x, final_norm_g)
```

```cpp
#include <hip/hip_runtime.h>
#include <hip/hip_cooperative_groups.h>
#include <cstdio>
#include <cstring>
namespace cg = cooperative_groups;

typedef unsigned short bf16_t;
using bf16x8 = __attribute__((ext_vector_type(8))) short;
using f32x16 = __attribute__((ext_vector_type(16))) float;

constexpr int T = 32768, DM = 1024, NB = 16, SEQ = 2048, DEPTH = 4, DFF = 2816;
constexpr int NPH_LAYER = 14, NPH = 1 + NPH_LAYER * DEPTH + 1;
constexpr int NT = 512, NW = 8, LDS_BYTES = 147456;
constexpr size_t MiB = 1u << 20;
constexpr size_t WS_CTL = 0, WS_MOD = 1 * MiB, WS_ROPE = 4 * MiB, WS_WBF = 8 * MiB, WS_H = 60 * MiB, WS_R = 124 * MiB;
constexpr size_t WS_ACT = WS_R;
constexpr size_t WS_PRKV = WS_R;
constexpr size_t WS_SBQKV = WS_R + 72 * MiB;
constexpr size_t WS_MERGED = WS_SBQKV;
constexpr size_t WS_PLORA = WS_R + 144 * MiB;
constexpr size_t WS_CQ = WS_R + 180 * MiB;
constexpr size_t WS_Y = WS_PLORA;
constexpr size_t WS_LA = WS_R + 232 * MiB;
constexpr size_t WS_CQN = WS_R + 252 * MiB;
constexpr size_t WS_KROPE = WS_R + 276 * MiB;
constexpr size_t WS_MLAQ = WS_R + 278 * MiB;
constexpr size_t WS_MLAKV = WS_R + 314 * MiB;
constexpr size_t WS_WL = WS_R + 362 * MiB;
constexpr size_t WS_AS = WS_R + 410 * MiB;
constexpr size_t WS_GG = WS_R + 458 * MiB;
constexpr size_t WS_GATES = WS_R + 232 * MiB;
constexpr size_t WS_WBF1 = WS_R + 482 * MiB;
constexpr size_t WS_END = WS_WBF1 + 52 * MiB;
constexpr size_t WO_W1IN = 0, WO_W1OUT = WO_W1IN + 5632 * 1024, WO_WIN = WO_W1OUT + 1024 * 2816, WO_WG = WO_WIN + 3072 * 1024,
                 WO_W2 = WO_WG + 3072 * 1024, WO_A2 = WO_W2 + 384 * 64, WO_G2 = WO_A2 + 384 * 64, WO_UQ = WO_G2 + 384 * 192,
                 WO_UKV = WO_UQ + 640 * 256, WO_BW = WO_UKV + 768 * 128, WO_WOUT = WO_BW + 3 * 1024 * 384,
                 WO_W2IN = WO_WOUT + 1024 * 1024, WO_W2OUT = WO_W2IN + 5632 * 1024, WO_END = WO_W2OUT + 1024 * 2816;
static_assert(WO_END * 2 <= 52 * MiB, "wbf");

struct Params {
  const float* in[29];
  float* out;
  unsigned char* ws;
  int ph_lo, ph_hi;
};
enum { I_X = 0, I_C, I_POS, I_ADAW, I_ADAB, I_NORMG, I_F1IN, I_F1OUT, I_MIXIN, I_MU, I_W0, I_W2, I_A0, I_A2, I_G2, I_KK, I_KA, I_RK,
       I_LNG, I_LNB, I_QNG, I_UQ, I_KVNG, I_UKV, I_BW, I_MIXOUT, I_F2IN, I_F2OUT, I_FING };

__device__ __forceinline__ unsigned short f2bf(float f) { unsigned u = __float_as_uint(f); u += 0x7fffu + ((u >> 16) & 1u); return (unsigned short)(u >> 16); }
__device__ __forceinline__ float bf2f(unsigned short b) { return __uint_as_float(((unsigned)b) << 16); }
template <int CTRL> __device__ __forceinline__ float dpp_f(float v) {
  return __builtin_bit_cast(float, __builtin_amdgcn_update_dpp(0, __builtin_bit_cast(int, v), CTRL, 0xF, 0xF, true));
}
__device__ __forceinline__ float sum8(float v) { v += dpp_f<0xB1>(v); v += dpp_f<0x4E>(v); v += dpp_f<0x141>(v); return v; }
__device__ __forceinline__ float wave_sum(float v) {
  v = sum8(v); v += dpp_f<0x140>(v);
  return (__builtin_bit_cast(float, __builtin_amdgcn_readlane(__builtin_bit_cast(int, v), 0)) + __builtin_bit_cast(float, __builtin_amdgcn_readlane(__builtin_bit_cast(int, v), 16)))
       + (__builtin_bit_cast(float, __builtin_amdgcn_readlane(__builtin_bit_cast(int, v), 32)) + __builtin_bit_cast(float, __builtin_amdgcn_readlane(__builtin_bit_cast(int, v), 48)));
}
__device__ __forceinline__ float shflx(const int tidx, float v, int mask) {
  return __builtin_bit_cast(float, __builtin_amdgcn_ds_bpermute(((tidx ^ mask) & 63) << 2, __builtin_bit_cast(int, v)));
}
__device__ __forceinline__ float sigmoidf_(float x) { return 1.f / (1.f + expf(-x)); }
__device__ __forceinline__ float softplusf_(float x) { return fmaxf(x, 0.f) + log1pf(expf(-fabsf(x))); }

template <int TN>
__device__ __forceinline__ void gemm_mainloop(const int tidx, const bf16_t* __restrict__ A, int lda, const bf16_t* __restrict__ Bt, int ldb, int K,
                                              int m0, int n0, unsigned char* smem, f32x16 (&acc)[2][TN]) {
  const int tid = tidx, lane = tid & 63, wid = tid >> 6, wm = wid >> 1, wn = wid & 1;
  const int r = lane & 31, h = lane >> 5;
  const int lr0 = tid >> 2, lc = tid & 3;
  const bool bload = (TN == 2) || (tid < 256);
  const bf16_t* ga0 = A + (size_t)(m0 + lr0) * lda + lc * 8;
  const bf16_t* ga1 = ga0 + (size_t)128 * lda;
  const bf16_t* gb0 = Bt + (size_t)(n0 + (bload ? lr0 : 0)) * ldb + lc * 8;
  const int lw0 = lr0 * 80 + lc * 16, lw1 = lw0 + 128 * 80;
#pragma unroll
  for (int a = 0; a < 2; ++a)
#pragma unroll
    for (int b = 0; b < TN; ++b)
#pragma unroll
      for (int i = 0; i < 16; ++i) acc[a][b][i] = 0.f;
  uint4 ra0 = *(const uint4*)ga0, ra1 = *(const uint4*)ga1, rb0 = *(const uint4*)gb0;
  *(uint4*)(smem + lw0) = ra0; *(uint4*)(smem + lw1) = ra1;
  if (bload) *(uint4*)(smem + 20480 + lw0) = rb0;
  __syncthreads();
  const int nk = K >> 5;
  const int aoff = (wm * 64 + r) * 80 + h * 16, boff = 20480 + (wn * 32 * TN + r) * 80 + h * 16;
  for (int kt = 0; kt < nk; ++kt) {
    unsigned char* cur = smem + (kt & 1) * 30720;
    const bool more = (kt + 1 < nk);
    if (more) {
      const int ko = (kt + 1) * 32;
      ra0 = *(const uint4*)(ga0 + ko); ra1 = *(const uint4*)(ga1 + ko);
      rb0 = *(const uint4*)(gb0 + ko);
    }
    __builtin_amdgcn_sched_barrier(0);
    {
      bf16x8 fa0[2], fa1[2], fb0[2], fb1[2];
#pragma unroll
      for (int s = 0; s < 2; ++s) {
        fa0[s] = *(const bf16x8*)(cur + aoff + s * 32);
        fa1[s] = *(const bf16x8*)(cur + aoff + 32 * 80 + s * 32);
        fb0[s] = *(const bf16x8*)(cur + boff + s * 32);
        fb1[s] = fb0[s];
        if (TN == 2) fb1[s] = *(const bf16x8*)(cur + boff + 32 * 80 + s * 32);
      }
      __builtin_amdgcn_sched_barrier(0);
#pragma unroll
      for (int s = 0; s < 2; ++s) {
        acc[0][0] = __builtin_amdgcn_mfma_f32_32x32x16_bf16(fb0[s], fa0[s], acc[0][0], 0, 0, 0);
        acc[1][0] = __builtin_amdgcn_mfma_f32_32x32x16_bf16(fb0[s], fa1[s], acc[1][0], 0, 0, 0);
        if (TN == 2) {
          acc[0][TN - 1] = __builtin_amdgcn_mfma_f32_32x32x16_bf16(fb1[s], fa0[s], acc[0][TN - 1], 0, 0, 0);
          acc[1][TN - 1] = __builtin_amdgcn_mfma_f32_32x32x16_bf16(fb1[s], fa1[s], acc[1][TN - 1], 0, 0, 0);
        }
      }
    }
    __builtin_amdgcn_sched_barrier(0);
    if (more) {
      unsigned char* nxt = smem + ((kt + 1) & 1) * 30720;
      *(uint4*)(nxt + lw0) = ra0; *(uint4*)(nxt + lw1) = ra1;
      if (bload) *(uint4*)(nxt + 20480 + lw0) = rb0;
    }
    __syncthreads();
  }
}

#define EPI4(TN_, acc, m0, n0, ...)                                                                         \
  {                                                                                                         \
    const int _lane = tidx & 63, _wid = tidx >> 6, _wm = _wid >> 1, _wn = _wid & 1;                         \
    const int _r = _lane & 31, _h = _lane >> 5;                                                             \
    _Pragma("unroll") for (int _tm = 0; _tm < 2; ++_tm) _Pragma("unroll") for (int _tn = 0; _tn < TN_; ++_tn) \
    _Pragma("unroll") for (int _g = 0; _g < 4; ++_g) {                                                      \
      const int row = (m0) + _wm * 64 + _tm * 32 + _r;                                                      \
      const int col0 = (n0) + _wn * 32 * TN_ + _tn * 32 + 8 * _g + 4 * _h;                                  \
      const float v0 = acc[_tm][_tn][4 * _g], v1 = acc[_tm][_tn][4 * _g + 1], v2 = acc[_tm][_tn][4 * _g + 2], v3 = acc[_tm][_tn][4 * _g + 3]; \
      const float q0 = acc[_tm][_tn][(4 * _g) ^ 8], q1 = acc[_tm][_tn][(4 * _g + 1) ^ 8], q2 = acc[_tm][_tn][(4 * _g + 2) ^ 8], q3 = acc[_tm][_tn][(4 * _g + 3) ^ 8]; \
      (void)q0; (void)q1; (void)q2; (void)q3;                                                               \
      __VA_ARGS__                                                                                           \
    }                                                                                                       \
  }
__device__ __forceinline__ uint2 pack4(float a, float b, float c, float d) {
  uint2 o; o.x = (unsigned)f2bf(a) | ((unsigned)f2bf(b) << 16); o.y = (unsigned)f2bf(c) | ((unsigned)f2bf(d) << 16); return o;
}

template <int MAP>
__device__ __forceinline__ void cvt_job(const int tidx, const float* __restrict__ W, int ldw, int K, int Kp, int ncols, int col0, bf16_t* __restrict__ dst,
                                        float scale, float* tl, unsigned* ctr) {
  const int tx = tidx & 63, ty = tidx >> 6;
  const int nkt = Kp >> 6, nct = (ncols + 63) >> 6;
  volatile int* sbox = (volatile int*)(tl + 64 * 65);
  for (;;) {
    if (tidx == 0) *sbox = (int)atomicAdd(ctr, 1u);
    __syncthreads();
    const int tile = *sbox;
    if (tile >= nkt * nct) break;
    const int k0 = (tile % nkt) * 64, c0 = (tile / nkt) * 64;
#pragma unroll 4
    for (int kk = ty; kk < 64; kk += NW) {
      const int k = k0 + kk, col = c0 + tx;
      tl[kk * 65 + tx] = (k < K && col < ncols) ? W[(size_t)k * ldw + col0 + col] : 0.f;
    }
    __syncthreads();
#pragma unroll 4
    for (int nn = ty; nn < 64; nn += NW) {
      const int col = c0 + nn;
      if (col < ncols) {
        int drow = col;
        if (MAP == 1) { drow = (col < DFF) ? ((col >> 4) * 32 + (col & 15)) : (((col - DFF) >> 4) * 32 + 16 + ((col - DFF) & 15)); }
        dst[(size_t)drow * Kp + k0 + tx] = f2bf(tl[tx * 65 + nn] * scale);
      }
    }
    __syncthreads();
  }
}
__device__ __forceinline__ void zero_bf16(const int tidx, bf16_t* dst, size_t n) {
  for (size_t i = (size_t)blockIdx.x * NT + tidx; i < n; i += (size_t)gridDim.x * NT) dst[i] = 0;
}

__device__ __forceinline__ void convert_layer(const int tidx, const Params& p, int l, unsigned char* smem) {
  bf16_t* wb = (bf16_t*)(p.ws + ((l & 1) ? WS_WBF1 : WS_WBF));
  unsigned* cc = (unsigned*)(p.ws + WS_CTL) + 16384 + 64 * l;
  float* tl = (float*)smem;
  cvt_job<1>(tidx, p.in[I_F1IN] + (size_t)l * 1024 * 5632, 5632, 1024, 1024, 5632, 0, wb + WO_W1IN, 1.f, tl, cc + 0);
  cvt_job<0>(tidx, p.in[I_F1OUT] + (size_t)l * 2816 * 1024, 1024, 2816, 2816, 1024, 0, wb + WO_W1OUT, 1.f, tl, cc + 1);
  cvt_job<0>(tidx, p.in[I_MIXIN] + (size_t)l * 1024 * 6080, 6080, 1024, 1024, 3008, 0, wb + WO_WIN, 1.f, tl, cc + 2);
  zero_bf16(tidx, wb + WO_WIN + (size_t)3008 * 1024, (size_t)64 * 1024);
  cvt_job<0>(tidx, p.in[I_MIXIN] + (size_t)l * 1024 * 6080, 6080, 1024, 1024, 3072, 3008, wb + WO_WG, 1.f, tl, cc + 3);
  cvt_job<0>(tidx, p.in[I_W2] + (size_t)l * 64 * 384, 384, 64, 64, 384, 0, wb + WO_W2, 1.f, tl, cc + 4);
  cvt_job<0>(tidx, p.in[I_A2] + (size_t)l * 64 * 384, 384, 64, 64, 384, 0, wb + WO_A2, 1.f, tl, cc + 5);
  cvt_job<0>(tidx, p.in[I_G2] + (size_t)l * 160 * 384, 384, 160, 192, 384, 0, wb + WO_G2, 1.f, tl, cc + 6);
  cvt_job<0>(tidx, p.in[I_UQ] + (size_t)l * 256 * 576, 576, 256, 256, 576, 0, wb + WO_UQ, 0.10206207261596575f, tl, cc + 7);
  zero_bf16(tidx, wb + WO_UQ + (size_t)576 * 256, (size_t)64 * 256);
  cvt_job<0>(tidx, p.in[I_UKV] + (size_t)l * 128 * 768, 768, 128, 128, 768, 0, wb + WO_UKV, 1.f, tl, cc + 8);
  for (int n = 0; n < 3; ++n)
    cvt_job<0>(tidx, p.in[I_BW] + ((size_t)l * 3 + n) * 384 * 1024, 1024, 384, 384, 1024, 0, wb + WO_BW + (size_t)n * 1024 * 384, 1.f, tl, cc + 9 + n);
  cvt_job<0>(tidx, p.in[I_MIXOUT] + (size_t)l * 1024 * 1024, 1024, 1024, 1024, 1024, 0, wb + WO_WOUT, 1.f, tl, cc + 12);
  cvt_job<1>(tidx, p.in[I_F2IN] + (size_t)l * 1024 * 5632, 5632, 1024, 1024, 5632, 0, wb + WO_W2IN, 1.f, tl, cc + 13);
  cvt_job<0>(tidx, p.in[I_F2OUT] + (size_t)l * 2816 * 1024, 1024, 2816, 2816, 1024, 0, wb + WO_W2OUT, 1.f, tl, cc + 14);
}

__device__ __forceinline__ void phase_mod(const int tidx, const Params& p, unsigned char* smem) {
  float* modb = (float*)(p.ws + WS_MOD);
  float* cs = (float*)smem;
  const float* c = p.in[I_C];
  const int tid = tidx;
  for (int it = blockIdx.x; it < DEPTH * 18 * 8; it += gridDim.x) {
    const int kc = it & 7, cc = (it >> 3) % 18, l = it / (18 * 8);
    const int k0 = kc * 128;
    for (int e = tid; e < 2048; e += NT) {
      const int kk = e >> 4, b = e & 15;
      const float cv = c[b * 1024 + k0 + kk];
      cs[kk * 16 + b] = cv / (1.f + expf(-cv));
    }
    __syncthreads();
    const int col = cc * NT + tid;
    float acc[16];
#pragma unroll
    for (int b = 0; b < 16; ++b) acc[b] = 0.f;
    const float* w = p.in[I_ADAW] + ((size_t)l * 1024 + k0) * 9216 + col;
#pragma unroll 16
    for (int kk = 0; kk < 128; ++kk) {
      const float wv = w[(size_t)kk * 9216];
      const float4* cp = (const float4*)(cs + kk * 16);
      const float4 c0 = cp[0], c1 = cp[1], c2 = cp[2], c3 = cp[3];
      acc[0] += c0.x * wv; acc[1] += c0.y * wv; acc[2] += c0.z * wv; acc[3] += c0.w * wv;
      acc[4] += c1.x * wv; acc[5] += c1.y * wv; acc[6] += c1.z * wv; acc[7] += c1.w * wv;
      acc[8] += c2.x * wv; acc[9] += c2.y * wv; acc[10] += c2.z * wv; acc[11] += c2.w * wv;
      acc[12] += c3.x * wv; acc[13] += c3.y * wv; acc[14] += c3.z * wv; acc[15] += c3.w * wv;
    }
    const float bias = (kc == 0) ? p.in[I_ADAB][l * 9216 + col] : 0.f;
#pragma unroll
    for (int b = 0; b < 16; ++b) atomicAdd(&modb[((size_t)l * 16 + b) * 9216 + col], acc[b] + bias);
    __syncthreads();
  }
}
__device__ __forceinline__ void phase_rope(const int tidx, const Params& p) {
  float* rope = (float*)(p.ws + WS_ROPE);
  const int* pos = (const int*)p.in[I_POS];
  for (int e = blockIdx.x * NT + tidx; e < T * 16; e += gridDim.x * NT) {
    const int t = e >> 4, i = e & 15;
    const float invf = 1.0f / powf(10000.0f, (float)(2 * i) / 32.0f);
    const float ang = (float)pos[t] * invf;
    double x = (double)ang;
    x -= rint(x * 0.15915494309189535) * 6.283185307179586;
    const float xr = (float)x;
    rope[(size_t)t * 32 + i] = cosf(xr);
    rope[(size_t)t * 32 + 16 + i] = sinf(xr);
  }
}

__device__ __forceinline__ void phase_modnorm(const int tidx, const Params& p, int l, int sub, const float* xsrc) {
  bf16_t* H = (bf16_t*)(p.ws + WS_H);
  const float* modb = (const float*)(p.ws + WS_MOD) + (size_t)l * 16 * 9216;
  const float* g = p.in[I_NORMG] + ((size_t)l * 3 + sub) * 1024;
  const int lane = tidx & 63, wid = tidx >> 6;
  const int stride = gridDim.x * NW;
  int row = blockIdx.x * NW + wid;
  float4 v[4], vn[4];
  float4 gg[4];
#pragma unroll
  for (int q = 0; q < 4; ++q) { gg[q] = *(const float4*)(g + q * 256 + lane * 4); v[q] = *(const float4*)(xsrc + (size_t)row * 1024 + q * 256 + lane * 4); }
  for (; row < T; row += stride) {
    const int nrow = row + stride;
    if (nrow < T) {
#pragma unroll
      for (int q = 0; q < 4; ++q) vn[q] = *(const float4*)(xsrc + (size_t)nrow * 1024 + q * 256 + lane * 4);
    }
    const int b = row >> 11;
    const float* sh = modb + (size_t)b * 9216 + sub * 3072;
    const float* sc = sh + 1024;
    float ss = 0.f;
#pragma unroll
    for (int q = 0; q < 4; ++q) ss += v[q].x * v[q].x + v[q].y * v[q].y + v[q].z * v[q].z + v[q].w * v[q].w;
    ss = wave_sum(ss);
    const float rstd = rsqrtf(ss * (1.f / 1024.f) + 1e-6f);
#pragma unroll
    for (int q = 0; q < 4; ++q) {
      const int c0 = q * 256 + lane * 4;
      const float4 s4 = *(const float4*)(sc + c0), h4 = *(const float4*)(sh + c0);
      const float o0 = v[q].x * rstd * gg[q].x * (1.f + s4.x) + h4.x;
      const float o1 = v[q].y * rstd * gg[q].y * (1.f + s4.y) + h4.y;
      const float o2 = v[q].z * rstd * gg[q].z * (1.f + s4.z) + h4.z;
      const float o3 = v[q].w * rstd * gg[q].w * (1.f + s4.w) + h4.w;
      uint2 o;
      o.x = (unsigned)f2bf(o0) | ((unsigned)f2bf(o1) << 16);
      o.y = (unsigned)f2bf(o2) | ((unsigned)f2bf(o3) << 16);
      *(uint2*)(H + (size_t)row * 1024 + c0) = o;
    }
#pragma unroll
    for (int q = 0; q < 4; ++q) v[q] = vn[q];
  }
}

namespace pg8 {
#define PG8_LAS __attribute__((address_space(3)))
typedef float f32x4 __attribute__((ext_vector_type(4)));
typedef unsigned u32x4 __attribute__((ext_vector_type(4)));
constexpr int BM = 256, BK = 64, HALF = 128, HTB = HALF * BK * 2, NXCD = 8, WGM = 8;
__host__ __device__ __forceinline__ int lds_byte(int r, int c) { const int st = (r >> 4) * 2 + (c >> 5), rr = r & 15, cc = c & 31, ob = rr * 64 + cc * 2; return st * 1024 + (ob ^ (((ob >> 9) & 1) << 5)); }
__host__ __device__ __forceinline__ void stage_rc(int b, int& R, int& C) { const int st = b / 1024, sb = b % 1024, swz = sb ^ (((sb >> 9) & 1) << 5); R = (st >> 1) * 16 + swz / 64; C = (st & 1) * 32 + (swz % 64) / 2; }
__host__ __device__ __forceinline__ int perm32(int rho) { const int n = rho >> 4, i = rho & 15; return 8 * (i >> 2) + 4 * n + (i & 3); }
struct Unit { int pm, pn; };
struct Gemm { const bf16_t* A; const bf16_t* Bt; int M, N, K, lda, ldb; };
struct StaticOrder {
    int nM, nN, nwg, G, c;
    __host__ __device__ void init(int M, int N, int G_, int c_) { nM = M / BM; nN = N / BM; nwg = nM * nN; G = G_; c = c_; }
    __host__ __device__ bool next(int i, Unit& u) const {
        const long L = (long)i * G + c; if (L >= nwg) return false;
        int wgid = (int)L; { const int q = nwg / NXCD, r = nwg % NXCD, xcd = wgid % NXCD, off = wgid / NXCD; wgid = (xcd < r ? xcd * (q + 1) : r * (q + 1) + (xcd - r) * q) + off; }
        const int nig = WGM * nN, gid = wgid / nig, fm = gid * WGM, gsz = (nM - fm) < WGM ? (nM - fm) : WGM;
        u.pm = fm + ((wgid % nig) % gsz); u.pn = (wgid % nig) / gsz; return true;
    }
    __device__ __forceinline__ void a_ready(const Unit&) const {}
    __device__ __forceinline__ void done(const Unit&) const {}
};
__device__ __forceinline__ unsigned cvt_pk_bf16(float lo, float hi) { unsigned r; asm volatile("v_cvt_pk_bf16_f32 %0, %1, %2" : "=v"(r) : "v"(lo), "v"(hi)); return r; }
__device__ __forceinline__ float fsig(float x) { return __builtin_amdgcn_rcpf(1.f + __expf(-x)); }

struct EpiFfnIn {
    static constexpr bool PERM = true, AFTER_DRAIN = false;
    bf16_t* ACT;
    __device__ __forceinline__ void operator()(const f32x4 (&acc)[2][2][4][2], const Unit& u, int wr, int wc, int fr, int fq) const {
#pragma unroll
        for (int ai = 0; ai < 2; ++ai)
#pragma unroll
            for (int m = 0; m < 4; ++m) {
                const int row = u.pm * BM + ai * HALF + wr * 64 + m * 16 + fr;
#pragma unroll
                for (int bj = 0; bj < 2; ++bj) {
                    const int ocol = ((u.pn * BM + bj * HALF + wc * 32) >> 1) + 4 * fq;
                    const f32x4 g = acc[ai][bj][m][0], up = acc[ai][bj][m][1];
                    uint2 o;
                    o.x = cvt_pk_bf16(g[0] * fsig(g[0]) * up[0], g[1] * fsig(g[1]) * up[1]);
                    o.y = cvt_pk_bf16(g[2] * fsig(g[2]) * up[2], g[3] * fsig(g[3]) * up[3]);
                    *(uint2*)(ACT + (size_t)row * DFF + ocol) = o;
                }
            }
    }
};
struct EpiResid {
    static constexpr bool PERM = true, AFTER_DRAIN = false;
    const float* xsrc; float* xdst; const float* gate; float coef;
    __device__ __forceinline__ void operator()(const f32x4 (&acc)[2][2][4][2], const Unit& u, int wr, int wc, int fr, int fq) const {
        const float* gb = gate + (size_t)((u.pm * BM) >> 11) * 9216;
#pragma unroll
        for (int bj = 0; bj < 2; ++bj) {
            const int c0 = u.pn * BM + bj * HALF + wc * 32 + 8 * fq;
            const f32x4 g0 = *(const f32x4*)(gb + c0) * coef, g1 = *(const f32x4*)(gb + c0 + 4) * coef;
#pragma unroll
            for (int ai = 0; ai < 2; ++ai)
#pragma unroll
                for (int m = 0; m < 4; ++m) {
                    const int row = u.pm * BM + ai * HALF + wr * 64 + m * 16 + fr;
                    const size_t o = (size_t)row * 1024 + c0;
                    const f32x4 x0 = *(const f32x4*)(xsrc + o), x1 = *(const f32x4*)(xsrc + o + 4);
                    *(f32x4*)(xdst + o) = x0 + g0 * acc[ai][bj][m][0];
                    *(f32x4*)(xdst + o + 4) = x1 + g1 * acc[ai][bj][m][1];
                }
        }
    }
};
struct EpiMixIn {
    static constexpr bool PERM = true, AFTER_DRAIN = false;
    bf16_t* PRKV; float* PLORA; bf16_t* SBQKV; float* CQ;
    __device__ __forceinline__ void operator()(const f32x4 (&acc)[2][2][4][2], const Unit& u, int wr, int wc, int fr, int fq) const {
#pragma unroll
        for (int bj = 0; bj < 2; ++bj) {
            const int c0 = u.pn * BM + bj * HALF + wc * 32 + 8 * fq;
#pragma unroll
            for (int ai = 0; ai < 2; ++ai)
#pragma unroll
                for (int m = 0; m < 4; ++m) {
                    const int row = u.pm * BM + ai * HALF + wr * 64 + m * 16 + fr;
                    f32x4 v0 = acc[ai][bj][m][0], v1 = acc[ai][bj][m][1];
                    if (c0 < 1152) {
                        u32x4 w; w.x = cvt_pk_bf16(v0[0], v0[1]); w.y = cvt_pk_bf16(v0[2], v0[3]); w.z = cvt_pk_bf16(v1[0], v1[1]); w.w = cvt_pk_bf16(v1[2], v1[3]);
                        *(u32x4*)(PRKV + (size_t)row * 1152 + c0) = w;
                    } else if (c0 < 1440) {
                        float* d = PLORA + (size_t)row * 288 + (c0 - 1152);
                        *(f32x4*)d = v0; *(f32x4*)(d + 4) = v1;
                    } else if (c0 < 2592) {
                        const int c2 = c0 - 1440;
                        if (c2 < 384) { v0 = v0 * 0.125f; v1 = v1 * 0.125f; }
                        u32x4 w; w.x = cvt_pk_bf16(v0[0], v0[1]); w.y = cvt_pk_bf16(v0[2], v0[3]); w.z = cvt_pk_bf16(v1[0], v1[1]); w.w = cvt_pk_bf16(v1[2], v1[3]);
                        *(u32x4*)(SBQKV + (size_t)row * 1152 + c2) = w;
                    } else if (c0 < 3008) {
                        float* d = CQ + (size_t)row * 416 + (c0 - 2592);
                        *(f32x4*)d = v0; *(f32x4*)(d + 4) = v1;
                    }
                }
        }
    }
};
struct EpiGates {
    static constexpr bool PERM = true, AFTER_DRAIN = false;
    bf16_t* G;
    __device__ __forceinline__ void operator()(const f32x4 (&acc)[2][2][4][2], const Unit& u, int wr, int wc, int fr, int fq) const {
#pragma unroll
        for (int bj = 0; bj < 2; ++bj) {
            const int c0 = u.pn * BM + bj * HALF + wc * 32 + 8 * fq;
#pragma unroll
            for (int ai = 0; ai < 2; ++ai)
#pragma unroll
                for (int m = 0; m < 4; ++m) {
                    const int row = u.pm * BM + ai * HALF + wr * 64 + m * 16 + fr;
                    const f32x4 v0 = acc[ai][bj][m][0], v1 = acc[ai][bj][m][1];
                    u32x4 w; w.x = cvt_pk_bf16(fsig(v0[0]), fsig(v0[1])); w.y = cvt_pk_bf16(fsig(v0[2]), fsig(v0[3]));
                    w.z = cvt_pk_bf16(fsig(v1[0]), fsig(v1[1])); w.w = cvt_pk_bf16(fsig(v1[2]), fsig(v1[3]));
                    *(u32x4*)(G + (size_t)row * 3072 + c0) = w;
                }
        }
    }
};

struct EpiAll {
    static constexpr bool PERM = true, AFTER_DRAIN = false;
    int mode; EpiFfnIn e0; EpiResid e1; EpiMixIn e2; EpiGates e3;
    __device__ __forceinline__ void operator()(const f32x4 (&acc)[2][2][4][2], const Unit& u, int wr, int wc, int fr, int fq) const {
        if (mode == 0) e0(acc, u, wr, wc, fr, fq);
        else if (mode == 1) e1(acc, u, wr, wc, fr, fq);
        else if (mode == 2) e2(acc, u, wr, wc, fr, fq);
        else e3(acc, u, wr, wc, fr, fq);
    }
};

}

#define G256_DB 1
template <bool TR>
__device__ __forceinline__ void gemm256_tile(const int tidx, const bf16_t* __restrict__ A, int lda, const bf16_t* __restrict__ Bt, int ldb, int K,
                                             int m0, int n0, unsigned char* smem, f32x16 (&acc)[4][2]) {
  const int tid = tidx, lane = tid & 63, wid = tid >> 6, wm = wid >> 2, wn = wid & 3;
  const int r = lane & 31, h = lane >> 5;
  const int lr = tid >> 3, lc = tid & 7;
  const bf16_t* ga = A + (size_t)(m0 + lr) * lda + lc * 8;
  const bf16_t* gb = Bt + (size_t)(n0 + lr) * ldb + lc * 8;
  const size_t sa = (size_t)64 * lda, sb = (size_t)64 * ldb;
  const int lw = lr * 144 + lc * 16;
  const int aoff = (wm * 128 + r) * 144 + h * 16, boff = 36864 + (wn * 64 + r) * 144 + h * 16;
#pragma unroll
  for (int a = 0; a < 4; ++a)
#pragma unroll
    for (int b = 0; b < 2; ++b)
#pragma unroll
      for (int i = 0; i < 16; ++i) acc[a][b][i] = 0.f;
  uint4 Pa0, Pa1, Pa2, Pa3, Pb0, Pb1, Pb2, Pb3;
#define G256_LOAD(ko) { Pa0 = *(const uint4*)(ga + (ko)); Pa1 = *(const uint4*)(ga + sa + (ko)); Pa2 = *(const uint4*)(ga + 2 * sa + (ko)); Pa3 = *(const uint4*)(ga + 3 * sa + (ko)); \
                        Pb0 = *(const uint4*)(gb + (ko)); Pb1 = *(const uint4*)(gb + sb + (ko)); Pb2 = *(const uint4*)(gb + 2 * sb + (ko)); Pb3 = *(const uint4*)(gb + 3 * sb + (ko)); }
#define G256_STORE(st) { unsigned char* _d = smem + (st) * 73728 + lw; \
    *(uint4*)(_d) = Pa0; *(uint4*)(_d + 64 * 144) = Pa1; *(uint4*)(_d + 128 * 144) = Pa2; *(uint4*)(_d + 192 * 144) = Pa3; \
    *(uint4*)(_d + 36864) = Pb0; *(uint4*)(_d + 36864 + 64 * 144) = Pb1; *(uint4*)(_d + 36864 + 128 * 144) = Pb2; *(uint4*)(_d + 36864 + 192 * 144) = Pb3; }
  G256_LOAD(0)
  G256_STORE(0)
  __syncthreads();
  const int nk = K >> 6;
  for (int kt = 0; kt < nk; ++kt) {
    const bool more = (kt + 1 < nk);
    if (more) G256_LOAD((kt + 1) * 64)
    __builtin_amdgcn_sched_barrier(0);
    const unsigned char* cbuf = smem + (kt & 1) * 73728;
    bf16x8 fb[2][2], fa[2][4];
#define G256_FRAGS(d, s_) { fb[d][0] = *(const bf16x8*)(cbuf + boff + (s_) * 32); fb[d][1] = *(const bf16x8*)(cbuf + boff + 32 * 144 + (s_) * 32); \
      _Pragma("unroll") for (int tm = 0; tm < 4; ++tm) fa[d][tm] = *(const bf16x8*)(cbuf + aoff + tm * 32 * 144 + (s_) * 32); }
    if (G256_DB) G256_FRAGS(0, 0)
#pragma unroll
    for (int s = 0; s < 4; ++s) {
      if (G256_DB) { if (s < 3) G256_FRAGS((s + 1) & 1, s + 1) }
      else G256_FRAGS(0, s)
      __builtin_amdgcn_sched_barrier(0);
      __builtin_amdgcn_s_setprio(2);
#pragma unroll
      for (int tm = 0; tm < 4; ++tm) {
        if (TR) {
          acc[tm][0] = __builtin_amdgcn_mfma_f32_32x32x16_bf16(fb[s & 1][0], fa[s & 1][tm], acc[tm][0], 0, 0, 0);
          acc[tm][1] = __builtin_amdgcn_mfma_f32_32x32x16_bf16(fb[s & 1][1], fa[s & 1][tm], acc[tm][1], 0, 0, 0);
        } else {
          acc[tm][0] = __builtin_amdgcn_mfma_f32_32x32x16_bf16(fa[s & 1][tm], fb[s & 1][0], acc[tm][0], 0, 0, 0);
          acc[tm][1] = __builtin_amdgcn_mfma_f32_32x32x16_bf16(fa[s & 1][tm], fb[s & 1][1], acc[tm][1], 0, 0, 0);
        }
        if (more && s >= 1 && s <= 2) {
          __builtin_amdgcn_sched_barrier(0);
          unsigned char* _d = smem + ((kt + 1) & 1) * 73728 + lw;
          if (s == 1) {
            if (tm == 0) *(uint4*)(_d) = Pa0;
            if (tm == 1) *(uint4*)(_d + 64 * 144) = Pa1;
            if (tm == 2) *(uint4*)(_d + 128 * 144) = Pa2;
            if (tm == 3) *(uint4*)(_d + 192 * 144) = Pa3;
          } else {
            if (tm == 0) *(uint4*)(_d + 36864) = Pb0;
            if (tm == 1) *(uint4*)(_d + 36864 + 64 * 144) = Pb1;
            if (tm == 2) *(uint4*)(_d + 36864 + 128 * 144) = Pb2;
            if (tm == 3) *(uint4*)(_d + 36864 + 192 * 144) = Pb3;
          }
          __builtin_amdgcn_sched_barrier(0);
        }
      }
      __builtin_amdgcn_s_setprio(0);
      __builtin_amdgcn_sched_barrier(0);
    }
#undef G256_FRAGS
    __syncthreads();
  }
#undef G256_LOAD
#undef G256_STORE
}
#define EPI4G(acc, m0, n0, ...)                                                                             \
  {                                                                                                         \
    const int _lane = tidx & 63, _wid = tidx >> 6, _wm = _wid >> 2, _wn = _wid & 3;                         \
    const int _r = _lane & 31, _h = _lane >> 5;                                                             \
    _Pragma("unroll") for (int _tm = 0; _tm < 4; ++_tm) _Pragma("unroll") for (int _tn = 0; _tn < 2; ++_tn) \
    _Pragma("unroll") for (int _g = 0; _g < 4; ++_g) {                                                      \
      const int row = (m0) + _wm * 128 + _tm * 32 + _r;                                                     \
      const int col0 = (n0) + _wn * 64 + _tn * 32 + 8 * _g + 4 * _h;                                        \
      const float v0 = acc[_tm][_tn][4 * _g], v1 = acc[_tm][_tn][4 * _g + 1], v2 = acc[_tm][_tn][4 * _g + 2], v3 = acc[_tm][_tn][4 * _g + 3]; \
      __VA_ARGS__                                                                                           \
    }                                                                                                       \
  }
__device__ __forceinline__ float fsig(float x) { return __builtin_amdgcn_rcpf(1.f + __expf(-x)); }

__device__ __forceinline__ void phase_big_resid(const int tidx, const int vid, unsigned char* smem, const bf16_t* A, int ld, const bf16_t* Bt, int N, int K, const pg8::EpiAll& E) {
  const int wsc = __builtin_amdgcn_readfirstlane(tidx >> 6);
  const int nN = N / 256, nwg = (T / 256) * nN, nig = 8 * nN;
  pg8::Unit u;
  for (int L = vid; L < nwg; L += (int)gridDim.x) {
    { const int gid = L / nig, rem = L % nig; u.pm = gid * 8 + (rem & 7); u.pn = rem >> 3; }
    const int m0 = u.pm * 256, n0 = u.pn * 256;
    f32x16 acc[4][2];
    {
      gemm256_tile<false>(tidx, A, ld, Bt, ld, K, m0, n0, smem, acc);
      int tidr;
    asm volatile("v_mbcnt_lo_u32_b32 %0, -1, 0\n\tv_mbcnt_hi_u32_b32 %0, -1, %0\n\tv_lshl_add_u32 %0, %1, 6, %0" : "=&v"(tidr) : "s"(wsc));
      const float* gb = E.e1.gate + (size_t)(m0 >> 11) * 9216;
      const int _lane = tidr & 63, _wid = tidr >> 6, _wm = _wid >> 2, _wn = _wid & 3, _r = _lane & 31, _h = _lane >> 5;
#pragma unroll
      for (int tn = 0; tn < 2; ++tn) {
        const int col = n0 + _wn * 64 + tn * 32 + _r;
        const float gc = E.e1.coef * gb[col];
#pragma unroll
        for (int tm = 0; tm < 4; ++tm) {
          const float* xs = E.e1.xsrc + (size_t)(m0 + _wm * 128 + tm * 32 + 4 * _h) * 1024 + col;
          float* xd = E.e1.xdst + (size_t)(m0 + _wm * 128 + tm * 32 + 4 * _h) * 1024 + col;
#pragma unroll
          for (int hf = 0; hf < 2; ++hf) {
            float xv[8];
#pragma unroll
            for (int i = 0; i < 8; ++i) xv[i] = xs[((i & 3) + 8 * ((i + 8 * hf) >> 2)) * 1024];
#pragma unroll
            for (int i = 0; i < 8; ++i) xd[((i & 3) + 8 * ((i + 8 * hf) >> 2)) * 1024] = xv[i] + gc * acc[tm][tn][i + 8 * hf];
            asm volatile("" ::: "memory");
          }
        }
      }
    }
  }
}

__device__ __forceinline__ void phase_big(const int tidx, const int vid, unsigned char* smem, const bf16_t* A, int ld, const bf16_t* Bt, int N, int K, const pg8::EpiAll& E) {
  const int wsc = __builtin_amdgcn_readfirstlane(tidx >> 6);
  const int nN = N / 256, nwg = (T / 256) * nN, nig = 8 * nN;
  pg8::Unit u;
  for (int L = vid; L < nwg; L += (int)gridDim.x) {
    { const int gid = L / nig, rem = L % nig; u.pm = gid * 8 + (rem & 7); u.pn = rem >> 3; }
    const int m0 = u.pm * 256, n0 = u.pn * 256;
    f32x16 acc[4][2];
    gemm256_tile<true>(tidx, A, ld, Bt, ld, K, m0, n0, smem, acc);
    int tidr;
    asm volatile("v_mbcnt_lo_u32_b32 %0, -1, 0\n\tv_mbcnt_hi_u32_b32 %0, -1, %0\n\tv_lshl_add_u32 %0, %1, 6, %0" : "=&v"(tidr) : "s"(wsc));
    {
    const int tidx = tidr;
    if (E.mode == 0) {
      const int _lane = tidx & 63, _wid = tidx >> 6, _wm = _wid >> 2, _wn = _wid & 3, _r = _lane & 31, _h = _lane >> 5;
#pragma unroll
      for (int tm = 0; tm < 4; ++tm)
#pragma unroll
        for (int tn = 0; tn < 2; ++tn)
#pragma unroll
          for (int g = 0; g < 2; ++g) {
            const int row = m0 + _wm * 128 + tm * 32 + _r;
            const int hcol = ((n0 + _wn * 64 + tn * 32) >> 1) + 8 * g + 4 * _h;
            const float g0 = acc[tm][tn][4 * g], g1 = acc[tm][tn][4 * g + 1], g2 = acc[tm][tn][4 * g + 2], g3 = acc[tm][tn][4 * g + 3];
            const float u0 = acc[tm][tn][4 * g + 8], u1 = acc[tm][tn][4 * g + 9], u2 = acc[tm][tn][4 * g + 10], u3 = acc[tm][tn][4 * g + 11];
            *(uint2*)(E.e0.ACT + (size_t)row * DFF + hcol) = pack4(g0 * fsig(g0) * u0, g1 * fsig(g1) * u1, g2 * fsig(g2) * u2, g3 * fsig(g3) * u3);
          }
    } else if (E.mode == 2) {
      EPI4G(acc, m0, n0, {
        if (col0 < 1152) *(uint2*)(E.e2.PRKV + (size_t)row * 1152 + col0) = pack4(v0, v1, v2, v3);
        else if (col0 < 1440) { float4 o; o.x = v0; o.y = v1; o.z = v2; o.w = v3; *(float4*)(E.e2.PLORA + (size_t)row * 288 + (col0 - 1152)) = o; }
        else if (col0 < 2592) { const int c2 = col0 - 1440; const float sc = (c2 < 384) ? 0.125f : 1.f; *(uint2*)(E.e2.SBQKV + (size_t)row * 1152 + c2) = pack4(v0 * sc, v1 * sc, v2 * sc, v3 * sc); }
        else if (col0 < 3008) { float4 o; o.x = v0; o.y = v1; o.z = v2; o.w = v3; *(float4*)(E.e2.CQ + (size_t)row * 416 + (col0 - 2592)) = o; }
      })
    } else {
      EPI4G(acc, m0, n0, { *(uint2*)(E.e3.G + (size_t)row * 3072 + col0) = pack4(fsig(v0), fsig(v1), fsig(v2), fsig(v3)); })
    }
    }
  }
}

__device__ __forceinline__ void phase_prep(const int tidx, const Params& p, int l) {
  const float* PLORA = (const float*)(p.ws + WS_PLORA);
  const float* CQ = (const float*)(p.ws + WS_CQ);
  const float* rope = (const float*)(p.ws + WS_ROPE);
  bf16_t* LA = (bf16_t*)(p.ws + WS_LA);
  bf16_t* CQN = (bf16_t*)(p.ws + WS_CQN);
  bf16_t* KROPE = (bf16_t*)(p.ws + WS_KROPE);
  const float* mu = p.in[I_MU] + (size_t)l * 1440 + 1152;
  const float* qg = p.in[I_QNG] + (size_t)l * 256;
  const float* kvg = p.in[I_KVNG] + (size_t)l * 128;
  const int lane = tidx & 63, wid = tidx >> 6;
  for (int row = blockIdx.x * NW + wid; row < T; row += gridDim.x * NW) {
    const bool hasprev = (row & 2047) != 0;
#pragma unroll
    for (int q = 0; q < 5; ++q) {
      const int c = lane + 64 * q;
      float o = 0.f;
      if (c < 288) {
        const float cur = PLORA[(size_t)row * 288 + c];
        const float prev = hasprev ? PLORA[(size_t)(row - 1) * 288 + c] : 0.f;
        const float xs = cur + (prev - cur) * mu[c];
        o = (c < 64) ? tanhf(xs) : ((c < 128) ? xs : sigmoidf_(xs));
      }
      LA[(size_t)row * 320 + c] = f2bf(o);
    }
    float vq[4], vk[2];
    float ssq = 0.f, ssk = 0.f;
#pragma unroll
    for (int q = 0; q < 4; ++q) { vq[q] = CQ[(size_t)row * 416 + lane + 64 * q]; ssq += vq[q] * vq[q]; }
#pragma unroll
    for (int q = 0; q < 2; ++q) { vk[q] = CQ[(size_t)row * 416 + 256 + lane + 64 * q]; ssk += vk[q] * vk[q]; }
    ssq = wave_sum(ssq); ssk = wave_sum(ssk);
    const float rq = rsqrtf(ssq * (1.f / 256.f) + 1e-6f), rk = rsqrtf(ssk * (1.f / 128.f) + 1e-6f);
#pragma unroll
    for (int q = 0; q < 4; ++q) CQN[(size_t)row * 384 + lane + 64 * q] = f2bf(vq[q] * rq * qg[lane + 64 * q]);
#pragma unroll
    for (int q = 0; q < 2; ++q) CQN[(size_t)row * 384 + 256 + lane + 64 * q] = f2bf(vk[q] * rk * kvg[lane + 64 * q]);
    const float kr = (lane < 32) ? CQ[(size_t)row * 416 + 384 + lane] : 0.f;
    const float other = shflx(tidx, kr, 16);
    if (lane < 32) {
      const int i = lane & 15;
      const float cs = rope[(size_t)row * 32 + i], sn = rope[(size_t)row * 32 + 16 + i];
      const float o = (lane < 16) ? (kr * cs - other * sn) : (kr * cs + other * sn);
      KROPE[(size_t)row * 32 + lane] = f2bf(o);
    }
  }
}

__device__ __forceinline__ void phase_small_gemms(const int tidx, const Params& p, int l, unsigned char* smem) {
  const bf16_t* wb = (const bf16_t*)(p.ws + ((l & 1) ? WS_WBF1 : WS_WBF));
  const bf16_t* LA = (const bf16_t*)(p.ws + WS_LA);
  const bf16_t* CQN = (const bf16_t*)(p.ws + WS_CQN);
  const float* rope = (const float*)(p.ws + WS_ROPE);
  float* WL = (float*)(p.ws + WS_WL);
  float* AS = (float*)(p.ws + WS_AS);
  bf16_t* GG = (bf16_t*)(p.ws + WS_GG);
  bf16_t* MLAQ = (bf16_t*)(p.ws + WS_MLAQ);
  bf16_t* MLAKV = (bf16_t*)(p.ws + WS_MLAKV);
  const float* w0 = p.in[I_W0] + (size_t)l * 384;
  const float* a0 = p.in[I_A0] + (size_t)l * 384;
  for (int tile = blockIdx.x; tile < (T / 256) * 20; tile += gridDim.x) {
    const int pm = tile / 20, j = tile % 20, m0 = pm * 256;
    f32x16 acc[2][2];
    if (j < 3) {
      const int n0 = j * 128;
      gemm_mainloop<2>(tidx, LA, 320, wb + WO_W2, 64, 64, m0, n0, smem, acc);
      EPI4(2, acc, m0, n0, {
        const float4 w4 = *(const float4*)(w0 + col0);
        float4 o;
        o.x = -expf(-softplusf_(-(w4.x + v0)) - 0.5f); o.y = -expf(-softplusf_(-(w4.y + v1)) - 0.5f);
        o.z = -expf(-softplusf_(-(w4.z + v2)) - 0.5f); o.w = -expf(-softplusf_(-(w4.w + v3)) - 0.5f);
        *(float4*)(WL + (size_t)row * 384 + col0) = o;
      })
    } else if (j < 6) {
      const int n0 = (j - 3) * 128;
      gemm_mainloop<2>(tidx, LA + 64, 320, wb + WO_A2, 64, 64, m0, n0, smem, acc);
      EPI4(2, acc, m0, n0, {
        const float4 a4 = *(const float4*)(a0 + col0);
        float4 o;
        o.x = sigmoidf_(a4.x + v0); o.y = sigmoidf_(a4.y + v1); o.z = sigmoidf_(a4.z + v2); o.w = sigmoidf_(a4.w + v3);
        *(float4*)(AS + (size_t)row * 384 + col0) = o;
      })
    } else if (j < 9) {
      const int n0 = (j - 6) * 128;
      gemm_mainloop<2>(tidx, LA + 128, 320, wb + WO_G2, 192, 192, m0, n0, smem, acc);
      EPI4(2, acc, m0, n0, { *(uint2*)(GG + (size_t)row * 384 + col0) = pack4(v0, v1, v2, v3); })
    } else if (j < 14) {
      const int n0 = (j - 9) * 128;
      gemm_mainloop<2>(tidx, CQN, 384, wb + WO_UQ, 256, 256, m0, n0, smem, acc);
      EPI4(2, acc, m0, n0, {
        const int cm = col0 % 96;
        float o0 = v0, o1 = v1, o2 = v2, o3 = v3;
        if (cm >= 64) {
          const int ii = (cm - 64) & 15;
          const float4 cs = *(const float4*)(rope + (size_t)row * 32 + ii), sn = *(const float4*)(rope + (size_t)row * 32 + 16 + ii);
          if (cm < 80) { o0 = v0 * cs.x - q0 * sn.x; o1 = v1 * cs.y - q1 * sn.y; o2 = v2 * cs.z - q2 * sn.z; o3 = v3 * cs.w - q3 * sn.w; }
          else { o0 = v0 * cs.x + q0 * sn.x; o1 = v1 * cs.y + q1 * sn.y; o2 = v2 * cs.z + q2 * sn.z; o3 = v3 * cs.w + q3 * sn.w; }
        }
        if (col0 < 576) *(uint2*)(MLAQ + (size_t)row * 576 + col0) = pack4(o0, o1, o2, o3);
      })
    } else {
      const int n0 = (j - 14) * 128;
      gemm_mainloop<2>(tidx, CQN + 256, 384, wb + WO_UKV, 128, 128, m0, n0, smem, acc);
      EPI4(2, acc, m0, n0, { *(uint2*)(MLAKV + (size_t)row * 768 + col0) = pack4(v0, v1, v2, v3); })
    }
  }
}

__device__ __forceinline__ void scan_item(const int tidx, const Params& p, int l, int b, int h, unsigned char* smem) {
  const bf16_t* PRKV = (const bf16_t*)(p.ws + WS_PRKV);
  const float* WL = (const float*)(p.ws + WS_WL);
  const float* AS = (const float*)(p.ws + WS_AS);
  const bf16_t* GG = (const bf16_t*)(p.ws + WS_GG);
  bf16_t* Y = (bf16_t*)(p.ws + WS_Y);
  float* sr = (float*)smem;
  float* sw = sr + 2048;
  float* sk = sw + 2048;
  float* sv = sk + 2048;
  float* sa = sv + 2048;
  float* sb = sa + 2048;
  float* sy = sb + 2048;
  float* sbon = sy + 2048;
  const int tid = tidx, lane = tid & 63, wid = tid >> 6;
  const int hc = h * 64 + lane;
  const float mur = p.in[I_MU][(size_t)l * 1440 + hc], muk = p.in[I_MU][(size_t)l * 1440 + 384 + hc], muv = p.in[I_MU][(size_t)l * 1440 + 768 + hc];
  const float kkc = p.in[I_KK][(size_t)l * 384 + hc], kac = p.in[I_KA][(size_t)l * 384 + hc], rkc = p.in[I_RK][(size_t)l * 384 + hc];
  const float lng = p.in[I_LNG][(size_t)l * 384 + hc], lnb = p.in[I_LNB][(size_t)l * 384 + hc];
  const int rp = (tid & 255) >> 3, g = tid & 7;
  typedef float f32x2 __attribute__((ext_vector_type(2)));
  f32x2 S2[8];
#pragma unroll
  for (int j = 0; j < 8; ++j) S2[j] = (f32x2){0.f, 0.f};
  unsigned short rr[4], rk[4], rv[4], rr1[4], rk1[4], rv1[4], rg[4], rgn[4];
  float rwl[4], ras[4];
#define SCAN_LOAD(t0_) {                                                                             \
    _Pragma("unroll") for (int q = 0; q < 4; ++q) {                                                  \
      const int t = (t0_) + wid * 4 + q;                                                             \
      const size_t row = (size_t)b * SEQ + t;                                                        \
      const bf16_t* pr = PRKV + row * 1152;                                                          \
      rr[q] = pr[hc]; rk[q] = pr[384 + hc]; rv[q] = pr[768 + hc];                                    \
      rr1[q] = 0; rk1[q] = 0; rv1[q] = 0;                                                            \
      if (t > 0) { rr1[q] = *(pr + hc - 1152); rk1[q] = *(pr + 384 + hc - 1152); rv1[q] = *(pr + 768 + hc - 1152); } \
      rwl[q] = WL[row * 384 + hc]; ras[q] = AS[row * 384 + hc]; rgn[q] = GG[row * 384 + hc];        \
    } }
  SCAN_LOAD(0)
  for (int t0 = 0; t0 < SEQ; t0 += 32) {
#pragma unroll
    for (int q = 0; q < 4; ++q) {
      const int tt = wid * 4 + q;
      float r = bf2f(rr[q]), k = bf2f(rk[q]), v = bf2f(rv[q]);
      const float r1 = bf2f(rr1[q]), k1 = bf2f(rk1[q]), v1 = bf2f(rv1[q]);
      r = r + (r1 - r) * mur; k = k + (k1 - k) * muk; v = v + (v1 - v) * muv;
      const float decay = expf(rwl[q]);
      const float as = ras[q];
      const float kkr = k * kkc;
      const float ss = wave_sum(kkr * kkr);
      const float kk = kkr * rsqrtf(fmaxf(ss, 1e-24f));
      const float k2 = k * (1.f + (as - 1.f) * kac);
      const float bon = wave_sum(r * k2 * rkc);
      sr[tt * 64 + lane] = r; sw[tt * 64 + lane] = decay; sk[tt * 64 + lane] = k2; sv[tt * 64 + lane] = v;
      sa[tt * 64 + lane] = -kk; sb[tt * 64 + lane] = kk * as;
      if (lane == 0) sbon[tt] = bon;
      rg[q] = rgn[q];
    }
    __syncthreads();
    if (t0 + 32 < SEQ) SCAN_LOAD(t0 + 32)
    if (wid < 4) {
#pragma unroll 8
      for (int tt = 0; tt < 32; ++tt) {
        const float4* pa = (const float4*)(sa + tt * 64 + g * 8);
        const float4* pw = (const float4*)(sw + tt * 64 + g * 8);
        const float4* pb = (const float4*)(sb + tt * 64 + g * 8);
        const float4* pk = (const float4*)(sk + tt * 64 + g * 8);
        const float4* prr = (const float4*)(sr + tt * 64 + g * 8);
        const float2 vi = *(const float2*)(sv + tt * 64 + 2 * rp);
        float av[8], wv[8], bv[8], kv[8], rv8[8];
#pragma unroll
        for (int q = 0; q < 2; ++q) {
          const float4 a4 = pa[q], w4 = pw[q], b4 = pb[q], k4 = pk[q], r4 = prr[q];
          av[q * 4] = a4.x; av[q * 4 + 1] = a4.y; av[q * 4 + 2] = a4.z; av[q * 4 + 3] = a4.w;
          wv[q * 4] = w4.x; wv[q * 4 + 1] = w4.y; wv[q * 4 + 2] = w4.z; wv[q * 4 + 3] = w4.w;
          bv[q * 4] = b4.x; bv[q * 4 + 1] = b4.y; bv[q * 4 + 2] = b4.z; bv[q * 4 + 3] = b4.w;
          kv[q * 4] = k4.x; kv[q * 4 + 1] = k4.y; kv[q * 4 + 2] = k4.z; kv[q * 4 + 3] = k4.w;
          rv8[q * 4] = r4.x; rv8[q * 4 + 1] = r4.y; rv8[q * 4 + 2] = r4.z; rv8[q * 4 + 3] = r4.w;
        }
        f32x2 sp_a = S2[0] * av[0] + S2[1] * av[1], sp_b = S2[2] * av[2] + S2[3] * av[3], sp_c = S2[4] * av[4] + S2[5] * av[5], sp_d = S2[6] * av[6] + S2[7] * av[7];
        const f32x2 sp = (sp_a + sp_b) + (sp_c + sp_d);
        const float sap0 = sum8(sp.x), sap1 = sum8(sp.y);
        const f32x2 sap2 = (f32x2){sap0, sap1}, vi2 = (f32x2){vi.x, vi.y};
        f32x2 yp_a = (f32x2){0.f, 0.f}, yp_b = (f32x2){0.f, 0.f};
#pragma unroll
        for (int j = 0; j < 8; j += 2) {
          S2[j] = S2[j] * wv[j] + sap2 * bv[j] + vi2 * kv[j];
          S2[j + 1] = S2[j + 1] * wv[j + 1] + sap2 * bv[j + 1] + vi2 * kv[j + 1];
          yp_a += S2[j] * rv8[j];
          yp_b += S2[j + 1] * rv8[j + 1];
        }
        const f32x2 ypv = yp_a + yp_b;
        const float yp0 = sum8(ypv.x), yp1 = sum8(ypv.y);
        if (g == 0) *(float2*)(sy + tt * 64 + 2 * rp) = make_float2(yp0, yp1);
      }
    }
    __syncthreads();
#pragma unroll
    for (int q = 0; q < 4; ++q) {
      const int tt = wid * 4 + q, t = t0 + tt;
      const size_t row = (size_t)b * SEQ + t;
      const float y = sy[tt * 64 + lane];
      const float mean = wave_sum(y) * (1.f / 64.f);
      const float d = y - mean;
      const float var = wave_sum(d * d) * (1.f / 64.f);
      const float yn = d * rsqrtf(var + 64e-5f) * lng + lnb;
      const float gg = bf2f(rg[q]);
      const float o = (yn + sbon[tt] * sv[tt * 64 + lane]) * gg;
      Y[row * 1152 + hc] = f2bf(o);
    }
    __syncthreads();
  }
#undef SCAN_LOAD
}

__device__ __forceinline__ void sb_item(const int tidx, const Params& p, int b, int h, int qb, unsigned char* smem) {
  const bf16_t* QKV = (const bf16_t*)(p.ws + WS_SBQKV);
  bf16_t* Y = (bf16_t*)(p.ws + WS_Y);
  float* Ks = (float*)smem;
  float* Vs = Ks + 4096;
  const int tid = tidx;
  const int t = qb * NT + tid;
  const size_t rowq = (size_t)b * SEQ + t;
  float q[64], o[64];
#pragma unroll
  for (int d = 0; d < 64; d += 8) {
    const uint4 u = *(const uint4*)(QKV + rowq * 1152 + h * 64 + d);
    q[d] = __uint_as_float(u.x << 16); q[d + 1] = __uint_as_float(u.x & 0xffff0000u);
    q[d + 2] = __uint_as_float(u.y << 16); q[d + 3] = __uint_as_float(u.y & 0xffff0000u);
    q[d + 4] = __uint_as_float(u.z << 16); q[d + 5] = __uint_as_float(u.z & 0xffff0000u);
    q[d + 6] = __uint_as_float(u.w << 16); q[d + 7] = __uint_as_float(u.w & 0xffff0000u);
  }
#pragma unroll
  for (int d = 0; d < 64; ++d) o[d] = 0.f;
  float run = 0.f;
  for (int kt = qb * 8 + 7; kt >= 0; --kt) {
    {
      const int kr = tid >> 3, dc = (tid & 7) * 8;
      const bf16_t* src = QKV + ((size_t)b * SEQ + kt * 64 + kr) * 1152 + h * 64 + dc;
#pragma unroll
      for (int e = 0; e < 8; ++e) { Ks[kr * 64 + dc + e] = bf2f(src[384 + e]); Vs[kr * 64 + dc + e] = bf2f(src[768 + e]); }
    }
    __syncthreads();
    for (int sl = 63; sl >= 0; --sl) {
      const int s = kt * 64 + sl;
      if (s < t) {
        const float4* kp = (const float4*)(Ks + sl * 64);
        float z = 0.f;
#pragma unroll
        for (int d4 = 0; d4 < 16; ++d4) { const float4 k4 = kp[d4]; z += q[d4 * 4] * k4.x + q[d4 * 4 + 1] * k4.y + q[d4 * 4 + 2] * k4.z + q[d4 * 4 + 3] * k4.w; }
        const float ln = -softplusf_(z);
        const float w = expf(z + ln + run);
        run += ln;
        const float4* vp = (const float4*)(Vs + sl * 64);
#pragma unroll
        for (int d4 = 0; d4 < 16; ++d4) { const float4 v4 = vp[d4]; o[d4 * 4] += w * v4.x; o[d4 * 4 + 1] += w * v4.y; o[d4 * 4 + 2] += w * v4.z; o[d4 * 4 + 3] += w * v4.w; }
      }
    }
    const bool alive = (run > -120.f);
    int* flag = (int*)(smem + 40960);
    if (tid == 0) *flag = 0;
    __syncthreads();
    if (__builtin_amdgcn_ballot_w64(alive) != 0ull && (tid & 63) == 0) *flag = 1;
    __syncthreads();
    const int any = *flag;
    __syncthreads();
    if (!any) break;
  }
  __syncthreads();
#pragma unroll
  for (int d = 0; d < 64; d += 2) {
    *(unsigned*)(Y + rowq * 1152 + 384 + h * 64 + d) = (unsigned)f2bf(o[d]) | ((unsigned)f2bf(o[d + 1]) << 16);
  }
}

__device__ __forceinline__ void mla_item(const int tidx, const Params& p, int b, int h, int qb, unsigned char* smem) {
  const bf16_t* MQ = (const bf16_t*)(p.ws + WS_MLAQ);
  const bf16_t* MKV = (const bf16_t*)(p.ws + WS_MLAKV);
  const bf16_t* KR = (const bf16_t*)(p.ws + WS_KROPE);
  bf16_t* Y = (bf16_t*)(p.ws + WS_Y);
  float* Ks = (float*)smem;
  float* Vs = Ks + 64 * 96;
  const int tid = tidx;
  const int t = qb * NT + tid;
  const size_t rowq = (size_t)b * SEQ + t;
  unsigned qp[48];
  float o[64];
#pragma unroll
  for (int d = 0; d < 12; ++d) {
    const uint4 u = *(const uint4*)(MQ + rowq * 576 + h * 96 + d * 8);
    qp[d * 4] = u.x; qp[d * 4 + 1] = u.y; qp[d * 4 + 2] = u.z; qp[d * 4 + 3] = u.w;
  }
#pragma unroll
  for (int d = 0; d < 64; ++d) o[d] = 0.f;
  float m = -1e30f, lsum = 0.f;
  for (int kt = 0; kt <= qb * 8 + 7; ++kt) {
    {
      const int kr = tid >> 3, part = tid & 7;
      const size_t rk = (size_t)b * SEQ + kt * 64 + kr;
      const bf16_t* srck = MKV + rk * 768 + h * 128 + part * 8;
      const bf16_t* srcv = srck + 64;
#pragma unroll
      for (int e = 0; e < 8; ++e) { Ks[kr * 96 + part * 8 + e] = bf2f(srck[e]); Vs[kr * 64 + part * 8 + e] = bf2f(srcv[e]); }
      const bf16_t* srcr = KR + rk * 32 + part * 4;
#pragma unroll
      for (int e = 0; e < 4; ++e) Ks[kr * 96 + 64 + part * 4 + e] = bf2f(srcr[e]);
    }
    __syncthreads();
    for (int sl = 0; sl < 64; ++sl) {
      const int s = kt * 64 + sl;
      if (s <= t) {
        const float4* kp = (const float4*)(Ks + sl * 96);
        float z = 0.f;
#pragma unroll
        for (int d4 = 0; d4 < 24; ++d4) { const float4 k4 = kp[d4]; const unsigned qa = qp[d4 * 2], qb2 = qp[d4 * 2 + 1];
          z += __uint_as_float(qa << 16) * k4.x + __uint_as_float(qa & 0xffff0000u) * k4.y + __uint_as_float(qb2 << 16) * k4.z + __uint_as_float(qb2 & 0xffff0000u) * k4.w; }
        if (z > m) {
          const float sc = expf(m - z);
          lsum *= sc;
#pragma unroll
          for (int d = 0; d < 64; ++d) o[d] *= sc;
          m = z;
        }
        const float w = expf(z - m);
        lsum += w;
        const float4* vp = (const float4*)(Vs + sl * 64);
#pragma unroll
        for (int d4 = 0; d4 < 16; ++d4) { const float4 v4 = vp[d4]; o[d4 * 4] += w * v4.x; o[d4 * 4 + 1] += w * v4.y; o[d4 * 4 + 2] += w * v4.z; o[d4 * 4 + 3] += w * v4.w; }
      }
    }
    __syncthreads();
  }
  const float inv = 1.f / lsum;
#pragma unroll
  for (int d = 0; d < 64; d += 2) {
    *(unsigned*)(Y + rowq * 1152 + 768 + h * 64 + d) = (unsigned)f2bf(o[d] * inv) | ((unsigned)f2bf(o[d + 1] * inv) << 16);
  }
}

__device__ __forceinline__ void mla_mfma_item(const int tidx, const Params& p, int b, int h, int qb, unsigned char* smem) {
  const bf16_t* MQ = (const bf16_t*)(p.ws + WS_MLAQ);
  const bf16_t* MKV = (const bf16_t*)(p.ws + WS_MLAKV);
  const bf16_t* KR = (const bf16_t*)(p.ws + WS_KROPE);
  bf16_t* Y = (bf16_t*)(p.ws + WS_Y);
  const int tid = tidx, lane = tid & 63, wid = tid >> 6, r = lane & 31, hh = lane >> 5;
  const int qw0 = qb * 256 + wid * 32;
  const size_t rowq = (size_t)b * SEQ + qw0 + r;
  bf16x8 qf[6];
#pragma unroll
  for (int s = 0; s < 6; ++s) qf[s] = *(const bf16x8*)(MQ + rowq * 576 + h * 96 + s * 16 + 8 * hh);
  f32x16 o[2];
#pragma unroll
  for (int i = 0; i < 16; ++i) { o[0][i] = 0.f; o[1][i] = 0.f; }
  float m = -1e30f, l = 0.f;
  const int ntiles = 4 * (qb + 1);
  const int skey = tid >> 3, sdc = tid & 7, rkey = (tid & 255) >> 2, rdc = tid & 3;
  const bf16_t* gk = MKV + ((size_t)b * SEQ + skey) * 768 + h * 128 + sdc * 8;
  const bf16_t* gr = KR + ((size_t)b * SEQ + rkey) * 32 + rdc * 8;
  uint4 kn = *(const uint4*)gk, vv = *(const uint4*)(gk + 64), kr4 = make_uint4(0, 0, 0, 0);
  if (tid < 256) kr4 = *(const uint4*)gr;
#define MLA_STORE(bufi) {                                                                             \
    unsigned char* _b = smem + (bufi) * 22016;                                                        \
    *(uint4*)(_b + skey * 208 + sdc * 16) = kn;                                                       \
    if (tid < 256) *(uint4*)(_b + rkey * 208 + 128 + rdc * 16) = kr4;                                 \
    unsigned short* _vt = (unsigned short*)(_b + 13312) + skey;                                       \
    const int _d0 = sdc * 8;                                                                          \
    _vt[(_d0 + 0) * 68] = (unsigned short)(vv.x & 0xffffu); _vt[(_d0 + 1) * 68] = (unsigned short)(vv.x >> 16); \
    _vt[(_d0 + 2) * 68] = (unsigned short)(vv.y & 0xffffu); _vt[(_d0 + 3) * 68] = (unsigned short)(vv.y >> 16); \
    _vt[(_d0 + 4) * 68] = (unsigned short)(vv.z & 0xffffu); _vt[(_d0 + 5) * 68] = (unsigned short)(vv.z >> 16); \
    _vt[(_d0 + 6) * 68] = (unsigned short)(vv.w & 0xffffu); _vt[(_d0 + 7) * 68] = (unsigned short)(vv.w >> 16); }
  MLA_STORE(0)
  __syncthreads();
  for (int kt = 0; kt < ntiles; ++kt) {
    if (kt + 1 < ntiles) {
      const size_t ko = (size_t)(kt + 1) * 64;
      kn = *(const uint4*)(gk + ko * 768); vv = *(const uint4*)(gk + ko * 768 + 64);
      if (tid < 256) kr4 = *(const uint4*)(gr + ko * 32);
    }
    if (kt * 64 <= qw0 + 31) {
      const unsigned char* Ks = smem + (kt & 1) * 22016;
      const unsigned char* Vt = Ks + 13312;
      f32x16 st[2];
#pragma unroll
      for (int kb = 0; kb < 2; ++kb) {
#pragma unroll
        for (int i = 0; i < 16; ++i) st[kb][i] = 0.f;
#pragma unroll
        for (int s = 0; s < 6; ++s) {
          const bf16x8 a = *(const bf16x8*)(Ks + (kb * 32 + r) * 208 + s * 32 + hh * 16);
          st[kb] = __builtin_amdgcn_mfma_f32_32x32x16_bf16(a, qf[s], st[kb], 0, 0, 0);
        }
      }
      if (kt * 64 + 63 > qw0) {
        const int qpos = qw0 + r;
#pragma unroll
        for (int kb = 0; kb < 2; ++kb)
#pragma unroll
          for (int i = 0; i < 16; ++i) {
            const int kpos = kt * 64 + kb * 32 + (i & 3) + 8 * (i >> 2) + 4 * hh;
            if (kpos > qpos) st[kb][i] = -1e30f;
          }
      }
      float mx = -1e30f;
#pragma unroll
      for (int kb = 0; kb < 2; ++kb)
#pragma unroll
        for (int i = 0; i < 16; ++i) mx = fmaxf(mx, st[kb][i]);
      mx = fmaxf(mx, shflx(tidx, mx, 32));
      const float mnew = fmaxf(m, mx);
      const float sc = __expf(m - mnew);
      m = mnew;
      float psum = 0.f;
#pragma unroll
      for (int kb = 0; kb < 2; ++kb)
#pragma unroll
        for (int i = 0; i < 16; ++i) { const float pv = __expf(st[kb][i] - mnew); st[kb][i] = pv; psum += pv; }
      psum += shflx(tidx, psum, 32);
      l = l * sc + psum;
#pragma unroll
      for (int i = 0; i < 16; ++i) { o[0][i] *= sc; o[1][i] *= sc; }
#pragma unroll
      for (int kb = 0; kb < 2; ++kb)
#pragma unroll
        for (int s2 = 0; s2 < 2; ++s2) {
          union { unsigned u[4]; bf16x8 v; } pk;
#pragma unroll
          for (int j = 0; j < 4; ++j) pk.u[j] = (unsigned)f2bf(st[kb][8 * s2 + 2 * j]) | ((unsigned)f2bf(st[kb][8 * s2 + 2 * j + 1]) << 16);
#pragma unroll
          for (int db = 0; db < 2; ++db) {
            const unsigned char* vp = Vt + (db * 32 + r) * 136 + (kb * 32 + 16 * s2 + 4 * hh) * 2;
            union { uint2 q2[2]; bf16x8 v; } va;
            va.q2[0] = *(const uint2*)vp; va.q2[1] = *(const uint2*)(vp + 16);
            o[db] = __builtin_amdgcn_mfma_f32_32x32x16_bf16(va.v, pk.v, o[db], 0, 0, 0);
          }
        }
    }
    if (kt + 1 < ntiles) MLA_STORE((kt + 1) & 1)
    __syncthreads();
  }
#undef MLA_STORE
  const float inv = 1.f / l;
#pragma unroll
  for (int db = 0; db < 2; ++db)
#pragma unroll
    for (int g = 0; g < 4; ++g) {
      const int d0 = db * 32 + 8 * g + 4 * hh;
      *(uint2*)(Y + rowq * 1152 + 768 + h * 64 + d0) = pack4(o[db][4 * g] * inv, o[db][4 * g + 1] * inv, o[db][4 * g + 2] * inv, o[db][4 * g + 3] * inv);
    }
}

__device__ __forceinline__ void sb_mfma_item(const int tidx, const Params& p, int b, int h, int qb, unsigned char* smem) {
  const bf16_t* QKV = (const bf16_t*)(p.ws + WS_SBQKV);
  bf16_t* Y = (bf16_t*)(p.ws + WS_Y);
  const int tid = tidx, lane = tid & 63, wid = tid >> 6, r = lane & 31, hh = lane >> 5;
  const int qw0 = qb * 256 + wid * 32;
  const int tq = qw0 + r;
  const size_t rowq = (size_t)b * SEQ + tq;
  bf16x8 qf[4];
#pragma unroll
  for (int s = 0; s < 4; ++s) qf[s] = *(const bf16x8*)(QKV + rowq * 1152 + h * 64 + s * 16 + 8 * hh);
  f32x16 o[2];
#pragma unroll
  for (int i = 0; i < 16; ++i) { o[0][i] = 0.f; o[1][i] = 0.f; }
  float run = 0.f;
  int* fl = (int*)(smem + 36864);
  const int skey = tid >> 3, sdc = tid & 7;
  const int ktmax = 4 * qb + 3;
  const bf16_t* gk = QKV + ((size_t)b * SEQ + skey) * 1152 + 384 + h * 64 + sdc * 8;
  uint4 kn = *(const uint4*)(gk + (size_t)ktmax * 64 * 1152), vv = *(const uint4*)(gk + (size_t)ktmax * 64 * 1152 + 384);
#define SB_STORE(bufi) {                                                                              \
    unsigned char* _b = smem + (bufi) * 17920;                                                        \
    *(uint4*)(_b + skey * 144 + sdc * 16) = kn;                                                       \
    unsigned short* _vt = (unsigned short*)(_b + 9216) + skey;                                        \
    const int _d0 = sdc * 8;                                                                          \
    _vt[(_d0 + 0) * 68] = (unsigned short)(vv.x & 0xffffu); _vt[(_d0 + 1) * 68] = (unsigned short)(vv.x >> 16); \
    _vt[(_d0 + 2) * 68] = (unsigned short)(vv.y & 0xffffu); _vt[(_d0 + 3) * 68] = (unsigned short)(vv.y >> 16); \
    _vt[(_d0 + 4) * 68] = (unsigned short)(vv.z & 0xffffu); _vt[(_d0 + 5) * 68] = (unsigned short)(vv.z >> 16); \
    _vt[(_d0 + 6) * 68] = (unsigned short)(vv.w & 0xffffu); _vt[(_d0 + 7) * 68] = (unsigned short)(vv.w >> 16); }
  SB_STORE(ktmax & 1)
  __syncthreads();
  for (int kt = ktmax; kt >= 0; --kt) {
    if (kt > 0) { const size_t ko = (size_t)(kt - 1) * 64 * 1152; kn = *(const uint4*)(gk + ko); vv = *(const uint4*)(gk + ko + 384); }
    const bool walive = __builtin_amdgcn_ballot_w64(run > -120.f) != 0ull;
    if (walive && kt * 64 <= qw0 + 30) {
      const unsigned char* Ks = smem + (kt & 1) * 17920;
      const unsigned char* Vt = Ks + 9216;
      f32x16 st[2];
#pragma unroll
      for (int kb = 0; kb < 2; ++kb) {
#pragma unroll
        for (int i = 0; i < 16; ++i) st[kb][i] = 0.f;
#pragma unroll
        for (int s = 0; s < 4; ++s) {
          const bf16x8 a = *(const bf16x8*)(Ks + (kb * 32 + r) * 144 + s * 32 + hh * 16);
          st[kb] = __builtin_amdgcn_mfma_f32_32x32x16_bf16(a, qf[s], st[kb], 0, 0, 0);
        }
      }
      const bool diag = (kt * 64 + 63 >= qw0);
      float ln[2][16], G[8];
#pragma unroll
      for (int kb = 0; kb < 2; ++kb)
#pragma unroll
        for (int g = 0; g < 4; ++g) {
          float gs = 0.f;
#pragma unroll
          for (int j = 0; j < 4; ++j) {
            const int i = 4 * g + j;
            const float z = st[kb][i];
            float v = -(fmaxf(z, 0.f) + __logf(1.f + __expf(-fabsf(z))));
            if (diag) { const int kpos = kt * 64 + kb * 32 + 8 * g + 4 * hh + j; if (kpos >= tq) v = 0.f; }
            ln[kb][i] = v; gs += v;
          }
          G[kb * 4 + g] = gs;
        }
      float Gp[8];
#pragma unroll
      for (int q = 0; q < 8; ++q) Gp[q] = shflx(tidx, G[q], 32);
      float aft[8];
      {
        float acc_o = 0.f, acc_p = 0.f;
#pragma unroll
        for (int q = 7; q >= 0; --q) {
          aft[q] = acc_o + acc_p + (hh == 0 ? Gp[q] : 0.f);
          acc_o += G[q]; acc_p += Gp[q];
        }
#pragma unroll
        for (int kb = 0; kb < 2; ++kb)
#pragma unroll
          for (int g = 0; g < 4; ++g) {
            float a3 = run + aft[kb * 4 + g];
#pragma unroll
            for (int j = 3; j >= 0; --j) {
              const int i = 4 * g + j;
              const float z = st[kb][i], l1 = ln[kb][i];
              float w = __expf(z + l1 + a3);
              if (diag) { const int kpos = kt * 64 + kb * 32 + 8 * g + 4 * hh + j; if (kpos >= tq) w = 0.f; }
              st[kb][i] = w;
              a3 += l1;
            }
          }
        run += acc_o + acc_p;
      }
#pragma unroll
      for (int kb = 0; kb < 2; ++kb)
#pragma unroll
        for (int s2 = 0; s2 < 2; ++s2) {
          union { unsigned u[4]; bf16x8 v; } pk;
#pragma unroll
          for (int j = 0; j < 4; ++j) pk.u[j] = (unsigned)f2bf(st[kb][8 * s2 + 2 * j]) | ((unsigned)f2bf(st[kb][8 * s2 + 2 * j + 1]) << 16);
#pragma unroll
          for (int db = 0; db < 2; ++db) {
            const unsigned char* vp = Vt + (db * 32 + r) * 136 + (kb * 32 + 16 * s2 + 4 * hh) * 2;
            union { uint2 q2[2]; bf16x8 v; } va;
            va.q2[0] = *(const uint2*)vp; va.q2[1] = *(const uint2*)(vp + 16);
            o[db] = __builtin_amdgcn_mfma_f32_32x32x16_bf16(va.v, pk.v, o[db], 0, 0, 0);
          }
        }
    }
    if (kt > 0) SB_STORE((kt - 1) & 1)
    const bool walive2 = __builtin_amdgcn_ballot_w64(run > -120.f) != 0ull;
    if (lane == 0) fl[(kt & 1) * 8 + wid] = walive2 ? 1 : 0;
    __syncthreads();
    int any = 0;
#pragma unroll
    for (int q = 0; q < 8; ++q) any |= fl[(kt & 1) * 8 + q];
    if (!any) break;
  }
#undef SB_STORE
  __syncthreads();
#pragma unroll
  for (int db = 0; db < 2; ++db)
#pragma unroll
    for (int g = 0; g < 4; ++g) {
      const int d0 = db * 32 + 8 * g + 4 * hh;
      *(uint2*)(Y + rowq * 1152 + 384 + h * 64 + d0) = pack4(o[db][4 * g], o[db][4 * g + 1], o[db][4 * g + 2], o[db][4 * g + 3]);
    }
}

__device__ __forceinline__ void phase_mixers(const int tidx, const Params& p, int l, unsigned char* smem) {
  volatile int* s_item_p = (volatile int*)(smem + 147440);
  unsigned* ctr = (unsigned*)(p.ws + WS_CTL) + 64 * l;
  for (;;) {
    if (tidx == 0) *s_item_p = (int)atomicAdd(ctr, 1u);
    __syncthreads();
    const int it = *s_item_p;
    __syncthreads();
    if (it >= 96 + 768 + 768) break;
    if (it < 96) {
#ifndef NO_SCAN
      scan_item(tidx, p, l, it / 6, it % 6, smem);
#endif
    } else {
      const int j = it - 96;
      if (j < 768) { const int qb = 7 - j / 96, jj = j % 96; mla_mfma_item(tidx, p, jj / 6, jj % 6, qb, smem); }
      else { const int j2 = j - 768, qb = 7 - j2 / 96, jj = j2 % 96; sb_mfma_item(tidx, p, jj / 6, jj % 6, qb, smem); }
    }
    __syncthreads();
  }
}

__device__ __forceinline__ void phase_merge(const int tidx, const Params& p, int l, unsigned char* smem) {
  const bf16_t* wb = (const bf16_t*)(p.ws + ((l & 1) ? WS_WBF1 : WS_WBF));
  const bf16_t* Y = (const bf16_t*)(p.ws + WS_Y);
  const bf16_t* GT = (const bf16_t*)(p.ws + WS_GATES);
  bf16_t* MG = (bf16_t*)(p.ws + WS_MERGED);
  constexpr int NTN = 8;
  for (int tile = blockIdx.x; tile < (T / 256) * NTN; tile += gridDim.x) {
    const int pm = tile / NTN, pn = tile % NTN, m0 = pm * 256, n0 = pn * 128;
    f32x16 tot[2][2];
#pragma unroll
    for (int a = 0; a < 2; ++a)
#pragma unroll
      for (int b = 0; b < 2; ++b)
#pragma unroll
        for (int i = 0; i < 16; ++i) tot[a][b][i] = 0.f;
#pragma unroll 1
    for (int n = 0; n < 3; ++n) {
      f32x16 acc[2][2];
      gemm_mainloop<2>(tidx, Y + n * 384, 1152, wb + WO_BW + (size_t)n * 1024 * 384, 384, 384, m0, n0, smem, acc);
      const bf16_t* gp = GT + n * 1024;
      {
        const int _lane = tidx & 63, _wid = tidx >> 6, _wm = _wid >> 1, _wn = _wid & 1, _r = _lane & 31, _h = _lane >> 5;
#pragma unroll
        for (int a = 0; a < 2; ++a)
#pragma unroll
          for (int b = 0; b < 2; ++b)
#pragma unroll
            for (int g = 0; g < 4; ++g) {
              const int row = m0 + _wm * 64 + a * 32 + _r;
              const int col0 = n0 + _wn * 64 + b * 32 + 8 * g + 4 * _h;
              const uint2 u = *(const uint2*)(gp + (size_t)row * 3072 + col0);
              tot[a][b][4 * g] += __uint_as_float(u.x << 16) * acc[a][b][4 * g];
              tot[a][b][4 * g + 1] += __uint_as_float(u.x & 0xffff0000u) * acc[a][b][4 * g + 1];
              tot[a][b][4 * g + 2] += __uint_as_float(u.y << 16) * acc[a][b][4 * g + 2];
              tot[a][b][4 * g + 3] += __uint_as_float(u.y & 0xffff0000u) * acc[a][b][4 * g + 3];
            }
      }
    }
    EPI4(2, tot, m0, n0, { *(uint2*)(MG + (size_t)row * 1024 + col0) = pack4(v0, v1, v2, v3); })
  }
}

__device__ __forceinline__ void phase_final(const int tidx, const Params& p) {
  const float* g = p.in[I_FING];
  float* X = p.out;
  const int lane = tidx & 63, wid = tidx >> 6;
  for (int row = blockIdx.x * NW + wid; row < T; row += gridDim.x * NW) {
    float* xr = X + (size_t)row * 1024;
    float4 v[4];
    float ss = 0.f;
#pragma unroll
    for (int q = 0; q < 4; ++q) {
      v[q] = *(const float4*)(xr + q * 256 + lane * 4);
      ss += v[q].x * v[q].x + v[q].y * v[q].y + v[q].z * v[q].z + v[q].w * v[q].w;
    }
    ss = wave_sum(ss);
    const float rstd = rsqrtf(ss * (1.f / 1024.f) + 1e-6f);
#pragma unroll
    for (int q = 0; q < 4; ++q) {
      const int c0 = q * 256 + lane * 4;
      const float4 gg = *(const float4*)(g + c0);
      float4 o;
      o.x = v[q].x * rstd * gg.x; o.y = v[q].y * rstd * gg.y; o.z = v[q].z * rstd * gg.z; o.w = v[q].w * rstd * gg.w;
      *(float4*)(xr + c0) = o;
    }
  }
}

__global__ void __launch_bounds__(NT, 2) mega(Params p) {
  extern __shared__ __attribute__((aligned(16))) unsigned char smem[];
#ifdef EXP_ZERO
  {
    const int t0 = hipThreadIdx_x;
    for (int i = t0; i < LDS_BYTES / 16; i += NT) ((uint4*)smem)[i] = make_uint4(0, 0, 0, 0);
    uint4* wz = (uint4*)(p.ws + WS_WBF);
    const size_t n16 = (WS_END - WS_WBF) / 16;
    for (size_t i = (size_t)hipBlockIdx_x * NT + t0; i < n16; i += (size_t)hipGridDim_x * NT) wz[i] = make_uint4(0, 0, 0, 0);
    __syncthreads();
  }
#endif
  const unsigned xcc = (unsigned)__builtin_amdgcn_s_getreg((3 << 11) | 20) & 0xFu;
  unsigned* xcnt = (unsigned*)(p.ws + WS_CTL) + 8192;
  if (hipThreadIdx_x == 0) ((volatile int*)smem)[0] = (int)__hip_atomic_fetch_add(xcnt + 32 * xcc, 1u, __ATOMIC_RELAXED, __HIP_MEMORY_SCOPE_AGENT);
  cg::this_grid().sync();
  if (hipThreadIdx_x == 0) {
    int base = 0;
    for (unsigned x = 0; x < xcc; ++x) base += (int)__hip_atomic_load(xcnt + 32 * x, __ATOMIC_RELAXED, __HIP_MEMORY_SCOPE_AGENT);
    ((volatile int*)smem)[0] += base;
  }
  __syncthreads();
  const int vid = __builtin_amdgcn_readfirstlane(((volatile int*)smem)[0]);
  __syncthreads();
  const int wave_id = __builtin_amdgcn_readfirstlane((int)hipThreadIdx_x >> 6);
  for (int ph = p.ph_lo; ph < p.ph_hi; ++ph) {
    int tidx;
    asm volatile("v_mbcnt_lo_u32_b32 %0, -1, 0\n\tv_mbcnt_hi_u32_b32 %0, -1, %0\n\tv_lshl_add_u32 %0, %1, 6, %0" : "=&v"(tidx) : "s"(wave_id));
    {
      unsigned long long wsv = (unsigned long long)p.ws;
      asm volatile("" : "+s"(wsv));
      p.ws = (unsigned char*)(__attribute__((address_space(1))) unsigned char*)wsv;
    }
    const bf16_t* wb0 = (const bf16_t*)(p.ws + WS_WBF);
    const float* modall = (const float*)(p.ws + WS_MOD);
    if (ph == 0) {
      phase_mod(tidx, p, smem);
      phase_rope(tidx, p);
      convert_layer(tidx, p, 0, smem);
    } else if (ph == NPH - 1) {
      phase_final(tidx, p);
    } else {
      const int l = (ph - 1) / NPH_LAYER, s = (ph - 1) % NPH_LAYER;
      const bf16_t* wb = (l & 1) ? (const bf16_t*)(p.ws + WS_WBF1) : wb0;
      const float* modl = modall + (size_t)l * 16 * 9216;
      const float* xcur = (l == 0 && s <= 2) ? p.in[I_X] : p.out;
      const bf16_t* Hb = (const bf16_t*)(p.ws + WS_H);
      pg8::EpiAll E;
      E.mode = -1;
      const bf16_t* gA = Hb; const bf16_t* gB = wb; int gld = 1024, gN = 1024, gK = 1024;
      bf16_t* ACTp = (bf16_t*)(p.ws + WS_ACT);
      E.e0.ACT = ACTp;
      E.e1.xsrc = p.out; E.e1.xdst = p.out; E.e1.gate = modl; E.e1.coef = 0.5f;
      E.e2.PRKV = (bf16_t*)(p.ws + WS_PRKV); E.e2.PLORA = (float*)(p.ws + WS_PLORA); E.e2.SBQKV = (bf16_t*)(p.ws + WS_SBQKV); E.e2.CQ = (float*)(p.ws + WS_CQ);
      E.e3.G = (bf16_t*)(p.ws + WS_GATES);
      switch (s) {
        case 0:
          phase_modnorm(tidx, p, l, 0, xcur);
          break;
        case 1: E.mode = 0; gB = wb + WO_W1IN; gN = 5632; break;
        case 2: E.mode = 1; E.e1.xsrc = xcur; E.e1.gate = modl + 0 * 3072 + 2048; gA = ACTp; gB = wb + WO_W1OUT; gld = DFF; gK = DFF; break;
        case 3: phase_modnorm(tidx, p, l, 1, p.out); break;
        case 4: E.mode = 2; gB = wb + WO_WIN; gN = 3072; break;
        case 5: phase_prep(tidx, p, l); break;
#ifndef NO_SMALL
        case 6: phase_small_gemms(tidx, p, l, smem); break;
#endif
#ifndef NO_MIX
        case 7:
          phase_mixers(tidx, p, l, smem);
          if (l + 1 < DEPTH) convert_layer(tidx, p, l + 1, smem);
          break;
#endif
        case 8: E.mode = 3; gB = wb + WO_WG; gN = 3072; break;
#ifndef NO_MERGE
        case 9: phase_merge(tidx, p, l, smem); break;
#endif
        case 10: E.mode = 1; E.e1.gate = modl + 1 * 3072 + 2048; E.e1.coef = 1.0f; gA = (const bf16_t*)(p.ws + WS_MERGED); gB = wb + WO_WOUT; break;
        case 11: phase_modnorm(tidx, p, l, 2, p.out); break;
        case 12: E.mode = 0; gB = wb + WO_W2IN; gN = 5632; break;
        case 13: E.mode = 1; E.e1.gate = modl + 2 * 3072 + 2048; gA = ACTp; gB = wb + WO_W2OUT; gld = DFF; gK = DFF; break;
      }
#ifndef NO_PG8
      if (E.mode == 1) phase_big_resid(tidx, vid, smem, gA, gld, gB, gN, gK, E);
      else if (E.mode >= 0) phase_big(tidx, vid, smem, gA, gld, gB, gN, gK, E);
#endif
    }
    if (ph + 1 < p.ph_hi) {
      unsigned* bar = (unsigned*)(p.ws + WS_CTL) + 1024 + 32 * ph;
      asm volatile("s_waitcnt vmcnt(0) lgkmcnt(0)" ::: "memory");
      __syncthreads();
      if (tidx == 0) {
        __builtin_amdgcn_fence(__ATOMIC_RELEASE, "agent");
        asm volatile("s_waitcnt vmcnt(0)" ::: "memory");
        __hip_atomic_fetch_add(bar, 1u, __ATOMIC_RELAXED, __HIP_MEMORY_SCOPE_AGENT);
        while (__hip_atomic_load(bar, __ATOMIC_RELAXED, __HIP_MEMORY_SCOPE_AGENT) < gridDim.x) __builtin_amdgcn_s_sleep(2);
        __builtin_amdgcn_fence(__ATOMIC_ACQUIRE, "agent");
        asm volatile("s_waitcnt vmcnt(0)" ::: "memory");
      }
      __syncthreads();
    }
  }
}

extern "C" void kernel_launch(void* const* d_in, const int* in_sizes, int n_in, void* d_out, int out_size,
                              void* d_ws, size_t ws_size, hipStream_t stream) {
  static int grid_blocks = 0;
  if (!grid_blocks) {
    int dev = 0, cus = 0, per_cu = 0;
    (void)hipGetDevice(&dev);
    (void)hipDeviceGetAttribute(&cus, hipDeviceAttributeMultiprocessorCount, dev);
    if (hipFuncSetAttribute((const void*)mega, hipFuncAttributeMaxDynamicSharedMemorySize, LDS_BYTES) != hipSuccess)
      fprintf(stderr, "hipFuncSetAttribute(max dynamic LDS) failed\n");
    (void)hipOccupancyMaxActiveBlocksPerMultiprocessor(&per_cu, mega, NT, LDS_BYTES);
    if (per_cu < 1) fprintf(stderr, "occupancy query says %d blocks/CU\n", per_cu);
    grid_blocks = cus;
    if (ws_size < WS_END) fprintf(stderr, "ws too small: %zu < %zu\n", ws_size, (size_t)WS_END);
    (void)hipGetLastError();
  }
  Params p;
  memset(&p, 0, sizeof p);
  for (int i = 0; i < 29; ++i) p.in[i] = (const float*)d_in[i];
  p.out = (float*)d_out;
  p.ws = (unsigned char*)d_ws;
  p.ph_lo = 0; p.ph_hi = NPH;
  (void)hipMemsetAsync(d_ws, 0, 4 * MiB, stream);
  void* args[] = {&p};
  hipError_t e = hipLaunchCooperativeKernel((void*)mega, dim3(grid_blocks), dim3(NT), args, LDS_BYTES, stream);
  if (e != hipSuccess) fprintf(stderr, "coop launch failed: %s\n", hipGetErrorString(e));
}
```

```cpp
#include <hip/hip_runtime.h>
#include <hip/hip_cooperative_groups.h>
#include <cstdio>
#include <cstring>
namespace cg = cooperative_groups;

typedef unsigned short bf16_t;
using bf16x8 = __attribute__((ext_vector_type(8))) short;
using f32x16 = __attribute__((ext_vector_type(16))) float;

constexpr int T = 32768, DM = 1024, NB = 16, SEQ = 2048, DEPTH = 4, DFF = 2816;
constexpr int NPH_LAYER = 14, NPH = 1 + NPH_LAYER * DEPTH + 1;
constexpr int NT = 512, NW = 8, LDS_BYTES = 147456;
constexpr size_t MiB = 1u << 20;
constexpr size_t WS_CTL = 0, WS_MOD = 1 * MiB, WS_ROPE = 4 * MiB, WS_WBF = 8 * MiB, WS_H = 60 * MiB, WS_R = 124 * MiB;
constexpr size_t WS_ACT = WS_R;
constexpr size_t WS_PRKV = WS_R;
constexpr size_t WS_SBQKV = WS_R + 72 * MiB;
constexpr size_t WS_MERGED = WS_SBQKV;
constexpr size_t WS_PLORA = WS_R + 144 * MiB;
constexpr size_t WS_CQ = WS_R + 180 * MiB;
constexpr size_t WS_Y = WS_PLORA;
constexpr size_t WS_LA = WS_R + 232 * MiB;
constexpr size_t WS_CQN = WS_R + 252 * MiB;
constexpr size_t WS_KROPE = WS_R + 276 * MiB;
constexpr size_t WS_MLAQ = WS_R + 278 * MiB;
constexpr size_t WS_MLAKV = WS_R + 314 * MiB;
constexpr size_t WS_WL = WS_R + 362 * MiB;
constexpr size_t WS_AS = WS_R + 410 * MiB;
constexpr size_t WS_GG = WS_R + 458 * MiB;
constexpr size_t WS_GATES = WS_R + 232 * MiB;
constexpr size_t WS_WBF1 = WS_R + 482 * MiB;
constexpr size_t WS_END = WS_WBF1 + 52 * MiB;
constexpr size_t WO_W1IN = 0, WO_W1OUT = WO_W1IN + 5632 * 1024, WO_WIN = WO_W1OUT + 1024 * 2816, WO_WG = WO_WIN + 3072 * 1024,
                 WO_W2 = WO_WG + 3072 * 1024, WO_A2 = WO_W2 + 384 * 64, WO_G2 = WO_A2 + 384 * 64, WO_UQ = WO_G2 + 384 * 192,
                 WO_UKV = WO_UQ + 640 * 256, WO_BW = WO_UKV + 768 * 128, WO_WOUT = WO_BW + 3 * 1024 * 384,
                 WO_W2IN = WO_WOUT + 1024 * 1024, WO_W2OUT = WO_W2IN + 5632 * 1024, WO_END = WO_W2OUT + 1024 * 2816;
static_assert(WO_END * 2 <= 52 * MiB, "wbf");

struct Params {
  const float* in[29];
  float* out;
  unsigned char* ws;
  int ph_lo, ph_hi;
};
enum { I_X = 0, I_C, I_POS, I_ADAW, I_ADAB, I_NORMG, I_F1IN, I_F1OUT, I_MIXIN, I_MU, I_W0, I_W2, I_A0, I_A2, I_G2, I_KK, I_KA, I_RK,
       I_LNG, I_LNB, I_QNG, I_UQ, I_KVNG, I_UKV, I_BW, I_MIXOUT, I_F2IN, I_F2OUT, I_FING };

__device__ __forceinline__ unsigned short f2bf(float f) { unsigned u = __float_as_uint(f); u += 0x7fffu + ((u >> 16) & 1u); return (unsigned short)(u >> 16); }
__device__ __forceinline__ float bf2f(unsigned short b) { return __uint_as_float(((unsigned)b) << 16); }
template <int CTRL> __device__ __forceinline__ float dpp_f(float v) {
  return __builtin_bit_cast(float, __builtin_amdgcn_update_dpp(0, __builtin_bit_cast(int, v), CTRL, 0xF, 0xF, true));
}
__device__ __forceinline__ float sum8(float v) { v += dpp_f<0xB1>(v); v += dpp_f<0x4E>(v); v += dpp_f<0x141>(v); return v; }
__device__ __forceinline__ float wave_sum(float v) {
  v = sum8(v); v += dpp_f<0x140>(v);
  return (__builtin_bit_cast(float, __builtin_amdgcn_readlane(__builtin_bit_cast(int, v), 0)) + __builtin_bit_cast(float, __builtin_amdgcn_readlane(__builtin_bit_cast(int, v), 16)))
       + (__builtin_bit_cast(float, __builtin_amdgcn_readlane(__builtin_bit_cast(int, v), 32)) + __builtin_bit_cast(float, __builtin_amdgcn_readlane(__builtin_bit_cast(int, v), 48)));
}
__device__ __forceinline__ float shflx(const int tidx, float v, int mask) {
  return __builtin_bit_cast(float, __builtin_amdgcn_ds_bpermute(((tidx ^ mask) & 63) << 2, __builtin_bit_cast(int, v)));
}
__device__ __forceinline__ float sigmoidf_(float x) { return 1.f / (1.f + expf(-x)); }
__device__ __forceinline__ float softplusf_(float x) { return fmaxf(x, 0.f) + log1pf(expf(-fabsf(x))); }

template <int TN>
__device__ __forceinline__ void gemm_mainloop(const int tidx, const bf16_t* __restrict__ A, int lda, const bf16_t* __restrict__ Bt, int ldb, int K,
                                              int m0, int n0, unsigned char* smem, f32x16 (&acc)[2][TN]) {
  const int tid = tidx, lane = tid & 63, wid = tid >> 6, wm = wid >> 1, wn = wid & 1;
  const int r = lane & 31, h = lane >> 5;
  const int lr0 = tid >> 2, lc = tid & 3;
  const bool bload = (TN == 2) || (tid < 256);
  const bf16_t* ga0 = A + (size_t)(m0 + lr0) * lda + lc * 8;
  const bf16_t* ga1 = ga0 + (size_t)128 * lda;
  const bf16_t* gb0 = Bt + (size_t)(n0 + (bload ? lr0 : 0)) * ldb + lc * 8;
  const int lw0 = lr0 * 80 + lc * 16, lw1 = lw0 + 128 * 80;
#pragma unroll
  for (int a = 0; a < 2; ++a)
#pragma unroll
    for (int b = 0; b < TN; ++b)
#pragma unroll
      for (int i = 0; i < 16; ++i) acc[a][b][i] = 0.f;
  uint4 ra0 = *(const uint4*)ga0, ra1 = *(const uint4*)ga1, rb0 = *(const uint4*)gb0;
  *(uint4*)(smem + lw0) = ra0; *(uint4*)(smem + lw1) = ra1;
  if (bload) *(uint4*)(smem + 20480 + lw0) = rb0;
  __syncthreads();
  const int nk = K >> 5;
  const int aoff = (wm * 64 + r) * 80 + h * 16, boff = 20480 + (wn * 32 * TN + r) * 80 + h * 16;
  for (int kt = 0; kt < nk; ++kt) {
    unsigned char* cur = smem + (kt & 1) * 30720;
    const bool more = (kt + 1 < nk);
    if (more) {
      const int ko = (kt + 1) * 32;
      ra0 = *(const uint4*)(ga0 + ko); ra1 = *(const uint4*)(ga1 + ko);
      rb0 = *(const uint4*)(gb0 + ko);
    }
    __builtin_amdgcn_sched_barrier(0);
    {
      bf16x8 fa0[2], fa1[2], fb0[2], fb1[2];
#pragma unroll
      for (int s = 0; s < 2; ++s) {
        fa0[s] = *(const bf16x8*)(cur + aoff + s * 32);
        fa1[s] = *(const bf16x8*)(cur + aoff + 32 * 80 + s * 32);
        fb0[s] = *(const bf16x8*)(cur + boff + s * 32);
        fb1[s] = fb0[s];
        if (TN == 2) fb1[s] = *(const bf16x8*)(cur + boff + 32 * 80 + s * 32);
      }
      __builtin_amdgcn_sched_barrier(0);
#pragma unroll
      for (int s = 0; s < 2; ++s) {
        acc[0][0] = __builtin_amdgcn_mfma_f32_32x32x16_bf16(fb0[s], fa0[s], acc[0][0], 0, 0, 0);
        acc[1][0] = __builtin_amdgcn_mfma_f32_32x32x16_bf16(fb0[s], fa1[s], acc[1][0], 0, 0, 0);
        if (TN == 2) {
          acc[0][TN - 1] = __builtin_amdgcn_mfma_f32_32x32x16_bf16(fb1[s], fa0[s], acc[0][TN - 1], 0, 0, 0);
          acc[1][TN - 1] = __builtin_amdgcn_mfma_f32_32x32x16_bf16(fb1[s], fa1[s], acc[1][TN - 1], 0, 0, 0);
        }
      }
    }
    __builtin_amdgcn_sched_barrier(0);
    if (more) {
      unsigned char* nxt = smem + ((kt + 1) & 1) * 30720;
      *(uint4*)(nxt + lw0) = ra0; *(uint4*)(nxt + lw1) = ra1;
      if (bload) *(uint4*)(nxt + 20480 + lw0) = rb0;
    }
    __syncthreads();
  }
}

#define EPI4(TN_, acc, m0, n0, ...)                                                                         \
  {                                                                                                         \
    const int _lane = tidx & 63, _wid = tidx >> 6, _wm = _wid >> 1, _wn = _wid & 1;                         \
    const int _r = _lane & 31, _h = _lane >> 5;                                                             \
    _Pragma("unroll") for (int _tm = 0; _tm < 2; ++_tm) _Pragma("unroll") for (int _tn = 0; _tn < TN_; ++_tn) \
    _Pragma("unroll") for (int _g = 0; _g < 4; ++_g) {                                                      \
      const int row = (m0) + _wm * 64 + _tm * 32 + _r;                                                      \
      const int col0 = (n0) + _wn * 32 * TN_ + _tn * 32 + 8 * _g + 4 * _h;                                  \
      const float v0 = acc[_tm][_tn][4 * _g], v1 = acc[_tm][_tn][4 * _g + 1], v2 = acc[_tm][_tn][4 * _g + 2], v3 = acc[_tm][_tn][4 * _g + 3]; \
      const float q0 = acc[_tm][_tn][(4 * _g) ^ 8], q1 = acc[_tm][_tn][(4 * _g + 1) ^ 8], q2 = acc[_tm][_tn][(4 * _g + 2) ^ 8], q3 = acc[_tm][_tn][(4 * _g + 3) ^ 8]; \
      (void)q0; (void)q1; (void)q2; (void)q3;                                                               \
      __VA_ARGS__                                                                                           \
    }                                                                                                       \
  }
__device__ __forceinline__ uint2 pack4(float a, float b, float c, float d) {
  uint2 o; o.x = (unsigned)f2bf(a) | ((unsigned)f2bf(b) << 16); o.y = (unsigned)f2bf(c) | ((unsigned)f2bf(d) << 16); return o;
}

template <int MAP>
__device__ __forceinline__ void cvt_job(const int tidx, const float* __restrict__ W, int ldw, int K, int Kp, int ncols, int col0, bf16_t* __restrict__ dst,
                                        float scale, float* tl, unsigned* ctr) {
  const int tx = tidx & 63, ty = tidx >> 6;
  const int nkt = Kp >> 6, nct = (ncols + 63) >> 6;
  volatile int* sbox = (volatile int*)(tl + 64 * 65);
  for (;;) {
    if (tidx == 0) *sbox = (int)atomicAdd(ctr, 1u);
    __syncthreads();
    const int tile = *sbox;
    if (tile >= nkt * nct) break;
    const int k0 = (tile % nkt) * 64, c0 = (tile / nkt) * 64;
#pragma unroll 4
    for (int kk = ty; kk < 64; kk += NW) {
      const int k = k0 + kk, col = c0 + tx;
      tl[kk * 65 + tx] = (k < K && col < ncols) ? W[(size_t)k * ldw + col0 + col] : 0.f;
    }
    __syncthreads();
#pragma unroll 4
    for (int nn = ty; nn < 64; nn += NW) {
      const int col = c0 + nn;
      if (col < ncols) {
        int drow = col;
        if (MAP == 1) { drow = (col < DFF) ? ((col >> 4) * 32 + (col & 15)) : (((col - DFF) >> 4) * 32 + 16 + ((col - DFF) & 15)); }
        dst[(size_t)drow * Kp + k0 + tx] = f2bf(tl[tx * 65 + nn] * scale);
      }
    }
    __syncthreads();
  }
}
__device__ __forceinline__ void zero_bf16(const int tidx, bf16_t* dst, size_t n) {
  for (size_t i = (size_t)blockIdx.x * NT + tidx; i < n; i += (size_t)gridDim.x * NT) dst[i] = 0;
}

__device__ __forceinline__ void convert_layer(const int tidx, const Params& p, int l, unsigned char* smem) {
  bf16_t* wb = (bf16_t*)(p.ws + ((l & 1) ? WS_WBF1 : WS_WBF));
  unsigned* cc = (unsigned*)(p.ws + WS_CTL) + 16384 + 64 * l;
  float* tl = (float*)smem;
  cvt_job<1>(tidx, p.in[I_F1IN] + (size_t)l * 1024 * 5632, 5632, 1024, 1024, 5632, 0, wb + WO_W1IN, 1.f, tl, cc + 0);
  cvt_job<0>(tidx, p.in[I_F1OUT] + (size_t)l * 2816 * 1024, 1024, 2816, 2816, 1024, 0, wb + WO_W1OUT, 1.f, tl, cc + 1);
  cvt_job<0>(tidx, p.in[I_MIXIN] + (size_t)l * 1024 * 6080, 6080, 1024, 1024, 3008, 0, wb + WO_WIN, 1.f, tl, cc + 2);
  zero_bf16(tidx, wb + WO_WIN + (size_t)3008 * 1024, (size_t)64 * 1024);
  cvt_job<0>(tidx, p.in[I_MIXIN] + (size_t)l * 1024 * 6080, 6080, 1024, 1024, 3072, 3008, wb + WO_WG, 1.f, tl, cc + 3);
  cvt_job<0>(tidx, p.in[I_W2] + (size_t)l * 64 * 384, 384, 64, 64, 384, 0, wb + WO_W2, 1.f, tl, cc + 4);
  cvt_job<0>(tidx, p.in[I_A2] + (size_t)l * 64 * 384, 384, 64, 64, 384, 0, wb + WO_A2, 1.f, tl, cc + 5);
  cvt_job<0>(tidx, p.in[I_G2] + (size_t)l * 160 * 384, 384, 160, 192, 384, 0, wb + WO_G2, 1.f, tl, cc + 6);
  cvt_job<0>(tidx, p.in[I_UQ] + (size_t)l * 256 * 576, 576, 256, 256, 576, 0, wb + WO_UQ, 0.10206207261596575f, tl, cc + 7);
  zero_bf16(tidx, wb + WO_UQ + (size_t)576 * 256, (size_t)64 * 256);
  cvt_job<0>(tidx, p.in[I_UKV] + (size_t)l * 128 * 768, 768, 128, 128, 768, 0, wb + WO_UKV, 1.f, tl, cc + 8);
  for (int n = 0; n < 3; ++n)
    cvt_job<0>(tidx, p.in[I_BW] + ((size_t)l * 3 + n) * 384 * 1024, 1024, 384, 384, 1024, 0, wb + WO_BW + (size_t)n * 1024 * 384, 1.f, tl, cc + 9 + n);
  cvt_job<0>(tidx, p.in[I_MIXOUT] + (size_t)l * 1024 * 1024, 1024, 1024, 1024, 1024, 0, wb + WO_WOUT, 1.f, tl, cc + 12);
  cvt_job<1>(tidx, p.in[I_F2IN] + (size_t)l * 1024 * 5632, 5632, 1024, 1024, 5632, 0, wb + WO_W2IN, 1.f, tl, cc + 13);
  cvt_job<0>(tidx, p.in[I_F2OUT] + (size_t)l * 2816 * 1024, 1024, 2816, 2816, 1024, 0, wb + WO_W2OUT, 1.f, tl, cc + 14);
}

__device__ __forceinline__ void phase_mod(const int tidx, const Params& p, unsigned char* smem) {
  float* modb = (float*)(p.ws + WS_MOD);
  float* cs = (float*)smem;
  const float* c = p.in[I_C];
  const int tid = tidx;
  for (int it = blockIdx.x; it < DEPTH * 18 * 8; it += gridDim.x) {
    const int kc = it & 7, cc = (it >> 3) % 18, l = it / (18 * 8);
    const int k0 = kc * 128;
    for (int e = tid; e < 2048; e += NT) {
      const int kk = e >> 4, b = e & 15;
      const float cv = c[b * 1024 + k0 + kk];
      cs[kk * 16 + b] = cv / (1.f + expf(-cv));
    }
    __syncthreads();
    const int col = cc * NT + tid;
    float acc[16];
#pragma unroll
    for (int b = 0; b < 16; ++b) acc[b] = 0.f;
    const float* w = p.in[I_ADAW] + ((size_t)l * 1024 + k0) * 9216 + col;
#pragma unroll 16
    for (int kk = 0; kk < 128; ++kk) {
      const float wv = w[(size_t)kk * 9216];
      const float4* cp = (const float4*)(cs + kk * 16);
      const float4 c0 = cp[0], c1 = cp[1], c2 = cp[2], c3 = cp[3];
      acc[0] += c0.x * wv; acc[1] += c0.y * wv; acc[2] += c0.z * wv; acc[3] += c0.w * wv;
      acc[4] += c1.x * wv; acc[5] += c1.y * wv; acc[6] += c1.z * wv; acc[7] += c1.w * wv;
      acc[8] += c2.x * wv; acc[9] += c2.y * wv; acc[10] += c2.z * wv; acc[11] += c2.w * wv;
      acc[12] += c3.x * wv; acc[13] += c3.y * wv; acc[14] += c3.z * wv; acc[15] += c3.w * wv;
    }
    const float bias = (kc == 0) ? p.in[I_ADAB][l * 9216 + col] : 0.f;
#pragma unroll
    for (int b = 0; b < 16; ++b) atomicAdd(&modb[((size_t)l * 16 + b) * 9216 + col], acc[b] + bias);
    __syncthreads();
  }
}
__device__ __forceinline__ void phase_rope(const int tidx, const Params& p) {
  float* rope = (float*)(p.ws + WS_ROPE);
  const int* pos = (const int*)p.in[I_POS];
  for (int e = blockIdx.x * NT + tidx; e < T * 16; e += gridDim.x * NT) {
    const int t = e >> 4, i = e & 15;
    const float invf = 1.0f / powf(10000.0f, (float)(2 * i) / 32.0f);
    const float ang = (float)pos[t] * invf;
    double x = (double)ang;
    x -= rint(x * 0.15915494309189535) * 6.283185307179586;
    const float xr = (float)x;
    rope[(size_t)t * 32 + i] = cosf(xr);
    rope[(size_t)t * 32 + 16 + i] = sinf(xr);
  }
}

__device__ __forceinline__ void phase_modnorm(const int tidx, const Params& p, int l, int sub, const float* xsrc) {
  bf16_t* H = (bf16_t*)(p.ws + WS_H);
  const float* modb = (const float*)(p.ws + WS_MOD) + (size_t)l * 16 * 9216;
  const float* g = p.in[I_NORMG] + ((size_t)l * 3 + sub) * 1024;
  const int lane = tidx & 63, wid = tidx >> 6;
  const int stride = gridDim.x * NW;
  int row = blockIdx.x * NW + wid;
  float4 v[4], vn[4];
  float4 gg[4];
#pragma unroll
  for (int q = 0; q < 4; ++q) { gg[q] = *(const float4*)(g + q * 256 + lane * 4); v[q] = *(const float4*)(xsrc + (size_t)row * 1024 + q * 256 + lane * 4); }
  for (; row < T; row += stride) {
    const int nrow = row + stride;
    if (nrow < T) {
#pragma unroll
      for (int q = 0; q < 4; ++q) vn[q] = *(const float4*)(xsrc + (size_t)nrow * 1024 + q * 256 + lane * 4);
    }
    const int b = row >> 11;
    const float* sh = modb + (size_t)b * 9216 + sub * 3072;
    const float* sc = sh + 1024;
    float ss = 0.f;
#pragma unroll
    for (int q = 0; q < 4; ++q) ss += v[q].x * v[q].x + v[q].y * v[q].y + v[q].z * v[q].z + v[q].w * v[q].w;
    ss = wave_sum(ss);
    const float rstd = rsqrtf(ss * (1.f / 1024.f) + 1e-6f);
#pragma unroll
    for (int q = 0; q < 4; ++q) {
      const int c0 = q * 256 + lane * 4;
      const float4 s4 = *(const float4*)(sc + c0), h4 = *(const float4*)(sh + c0);
      const float o0 = v[q].x * rstd * gg[q].x * (1.f + s4.x) + h4.x;
      const float o1 = v[q].y * rstd * gg[q].y * (1.f + s4.y) + h4.y;
      const float o2 = v[q].z * rstd * gg[q].z * (1.f + s4.z) + h4.z;
      const float o3 = v[q].w * rstd * gg[q].w * (1.f + s4.w) + h4.w;
      uint2 o;
      o.x = (unsigned)f2bf(o0) | ((unsigned)f2bf(o1) << 16);
      o.y = (unsigned)f2bf(o2) | ((unsigned)f2bf(o3) << 16);
      *(uint2*)(H + (size_t)row * 1024 + c0) = o;
    }
#pragma unroll
    for (int q = 0; q < 4; ++q) v[q] = vn[q];
  }
}

namespace pg8 {
#define PG8_LAS __attribute__((address_space(3)))
typedef float f32x4 __attribute__((ext_vector_type(4)));
typedef unsigned u32x4 __attribute__((ext_vector_type(4)));
constexpr int BM = 256, BK = 64, HALF = 128, HTB = HALF * BK * 2, NXCD = 8, WGM = 8;
__host__ __device__ __forceinline__ int lds_byte(int r, int c) { const int st = (r >> 4) * 2 + (c >> 5), rr = r & 15, cc = c & 31, ob = rr * 64 + cc * 2; return st * 1024 + (ob ^ (((ob >> 9) & 1) << 5)); }
__host__ __device__ __forceinline__ void stage_rc(int b, int& R, int& C) { const int st = b / 1024, sb = b % 1024, swz = sb ^ (((sb >> 9) & 1) << 5); R = (st >> 1) * 16 + swz / 64; C = (st & 1) * 32 + (swz % 64) / 2; }
__host__ __device__ __forceinline__ int perm32(int rho) { const int n = rho >> 4, i = rho & 15; return 8 * (i >> 2) + 4 * n + (i & 3); }
struct Unit { int pm, pn; };
struct Gemm { const bf16_t* A; const bf16_t* Bt; int M, N, K, lda, ldb; };
struct StaticOrder {
    int nM, nN, nwg, G, c;
    __host__ __device__ void init(int M, int N, int G_, int c_) { nM = M / BM; nN = N / BM; nwg = nM * nN; G = G_; c = c_; }
    __host__ __device__ bool next(int i, Unit& u) const {
        const long L = (long)i * G + c; if (L >= nwg) return false;
        int wgid = (int)L; { const int q = nwg / NXCD, r = nwg % NXCD, xcd = wgid % NXCD, off = wgid / NXCD; wgid = (xcd < r ? xcd * (q + 1) : r * (q + 1) + (xcd - r) * q) + off; }
        const int nig = WGM * nN, gid = wgid / nig, fm = gid * WGM, gsz = (nM - fm) < WGM ? (nM - fm) : WGM;
        u.pm = fm + ((wgid % nig) % gsz); u.pn = (wgid % nig) / gsz; return true;
    }
    __device__ __forceinline__ void a_ready(const Unit&) const {}
    __device__ __forceinline__ void done(const Unit&) const {}
};
__device__ __forceinline__ unsigned cvt_pk_bf16(float lo, float hi) { unsigned r; asm volatile("v_cvt_pk_bf16_f32 %0, %1, %2" : "=v"(r) : "v"(lo), "v"(hi)); return r; }
__device__ __forceinline__ float fsig(float x) { return __builtin_amdgcn_rcpf(1.f + __expf(-x)); }

struct EpiFfnIn {
    static constexpr bool PERM = true, AFTER_DRAIN = false;
    bf16_t* ACT;
    __device__ __forceinline__ void operator()(const f32x4 (&acc)[2][2][4][2], const Unit& u, int wr, int wc, int fr, int fq) const {
#pragma unroll
        for (int ai = 0; ai < 2; ++ai)
#pragma unroll
            for (int m = 0; m < 4; ++m) {
                const int row = u.pm * BM + ai * HALF + wr * 64 + m * 16 + fr;
#pragma unroll
                for (int bj = 0; bj < 2; ++bj) {
                    const int ocol = ((u.pn * BM + bj * HALF + wc * 32) >> 1) + 4 * fq;
                    const f32x4 g = acc[ai][bj][m][0], up = acc[ai][bj][m][1];
                    uint2 o;
                    o.x = cvt_pk_bf16(g[0] * fsig(g[0]) * up[0], g[1] * fsig(g[1]) * up[1]);
                    o.y = cvt_pk_bf16(g[2] * fsig(g[2]) * up[2], g[3] * fsig(g[3]) * up[3]);
                    *(uint2*)(ACT + (size_t)row * DFF + ocol) = o;
                }
            }
    }
};
struct EpiResid {
    static constexpr bool PERM = true, AFTER_DRAIN = false;
    const float* xsrc; float* xdst; const float* gate; float coef;
    __device__ __forceinline__ void operator()(const f32x4 (&acc)[2][2][4][2], const Unit& u, int wr, int wc, int fr, int fq) const {
        const float* gb = gate + (size_t)((u.pm * BM) >> 11) * 9216;
#pragma unroll
        for (int bj = 0; bj < 2; ++bj) {
            const int c0 = u.pn * BM + bj * HALF + wc * 32 + 8 * fq;
            const f32x4 g0 = *(const f32x4*)(gb + c0) * coef, g1 = *(const f32x4*)(gb + c0 + 4) * coef;
#pragma unroll
            for (int ai = 0; ai < 2; ++ai)
#pragma unroll
                for (int m = 0; m < 4; ++m) {
                    const int row = u.pm * BM + ai * HALF + wr * 64 + m * 16 + fr;
                    const size_t o = (size_t)row * 1024 + c0;
                    const f32x4 x0 = *(const f32x4*)(xsrc + o), x1 = *(const f32x4*)(xsrc + o + 4);
                    *(f32x4*)(xdst + o) = x0 + g0 * acc[ai][bj][m][0];
                    *(f32x4*)(xdst + o + 4) = x1 + g1 * acc[ai][bj][m][1];
                }
        }
    }
};
struct EpiMixIn {
    static constexpr bool PERM = true, AFTER_DRAIN = false;
    bf16_t* PRKV; float* PLORA; bf16_t* SBQKV; float* CQ;
    __device__ __forceinline__ void operator()(const f32x4 (&acc)[2][2][4][2], const Unit& u, int wr, int wc, int fr, int fq) const {
#pragma unroll
        for (int bj = 0; bj < 2; ++bj) {
            const int c0 = u.pn * BM + bj * HALF + wc * 32 + 8 * fq;
#pragma unroll
            for (int ai = 0; ai < 2; ++ai)
#pragma unroll
                for (int m = 0; m < 4; ++m) {
                    const int row = u.pm * BM + ai * HALF + wr * 64 + m * 16 + fr;
                    f32x4 v0 = acc[ai][bj][m][0], v1 = acc[ai][bj][m][1];
                    if (c0 < 1152) {
                        u32x4 w; w.x = cvt_pk_bf16(v0[0], v0[1]); w.y = cvt_pk_bf16(v0[2], v0[3]); w.z = cvt_pk_bf16(v1[0], v1[1]); w.w = cvt_pk_bf16(v1[2], v1[3]);
                        *(u32x4*)(PRKV + (size_t)row * 1152 + c0) = w;
                    } else if (c0 < 1440) {
                        float* d = PLORA + (size_t)row * 288 + (c0 - 1152);
                        *(f32x4*)d = v0; *(f32x4*)(d + 4) = v1;
                    } else if (c0 < 2592) {
                        const int c2 = c0 - 1440;
                        if (c2 < 384) { v0 = v0 * 0.125f; v1 = v1 * 0.125f; }
                        u32x4 w; w.x = cvt_pk_bf16(v0[0], v0[1]); w.y = cvt_pk_bf16(v0[2], v0[3]); w.z = cvt_pk_bf16(v1[0], v1[1]); w.w = cvt_pk_bf16(v1[2], v1[3]);
                        *(u32x4*)(SBQKV + (size_t)row * 1152 + c2) = w;
                    } else if (c0 < 3008) {
                        float* d = CQ + (size_t)row * 416 + (c0 - 2592);
                        *(f32x4*)d = v0; *(f32x4*)(d + 4) = v1;
                    }
                }
        }
    }
};
struct EpiGates {
    static constexpr bool PERM = true, AFTER_DRAIN = false;
    bf16_t* G;
    __device__ __forceinline__ void operator()(const f32x4 (&acc)[2][2][4][2], const Unit& u, int wr, int wc, int fr, int fq) const {
#pragma unroll
        for (int bj = 0; bj < 2; ++bj) {
            const int c0 = u.pn * BM + bj * HALF + wc * 32 + 8 * fq;
#pragma unroll
            for (int ai = 0; ai < 2; ++ai)
#pragma unroll
                for (int m = 0; m < 4; ++m) {
                    const int row = u.pm * BM + ai * HALF + wr * 64 + m * 16 + fr;
                    const f32x4 v0 = acc[ai][bj][m][0], v1 = acc[ai][bj][m][1];
                    u32x4 w; w.x = cvt_pk_bf16(fsig(v0[0]), fsig(v0[1])); w.y = cvt_pk_bf16(fsig(v0[2]), fsig(v0[3]));
                    w.z = cvt_pk_bf16(fsig(v1[0]), fsig(v1[1])); w.w = cvt_pk_bf16(fsig(v1[2]), fsig(v1[3]));
                    *(u32x4*)(G + (size_t)row * 3072 + c0) = w;
                }
        }
    }
};

struct EpiAll {
    static constexpr bool PERM = true, AFTER_DRAIN = false;
    int mode; EpiFfnIn e0; EpiResid e1; EpiMixIn e2; EpiGates e3;
    __device__ __forceinline__ void operator()(const f32x4 (&acc)[2][2][4][2], const Unit& u, int wr, int wc, int fr, int fq) const {
        if (mode == 0) e0(acc, u, wr, wc, fr, fq);
        else if (mode == 1) e1(acc, u, wr, wc, fr, fq);
        else if (mode == 2) e2(acc, u, wr, wc, fr, fq);
        else e3(acc, u, wr, wc, fr, fq);
    }
};

}

#define G256_DB 1
template <bool TR>
__device__ __forceinline__ void gemm256_tile(const int tidx, const bf16_t* __restrict__ A, int lda, const bf16_t* __restrict__ Bt, int ldb, int K,
                                             int m0, int n0, unsigned char* smem, f32x16 (&acc)[4][2]) {
  const int tid = tidx, lane = tid & 63, wid = tid >> 6, wm = wid >> 2, wn = wid & 3;
  const int r = lane & 31, h = lane >> 5;
  const int lr = tid >> 3, lc = tid & 7;
  const bf16_t* ga = A + (size_t)(m0 + lr) * lda + lc * 8;
  const bf16_t* gb = Bt + (size_t)(n0 + lr) * ldb + lc * 8;
  const size_t sa = (size_t)64 * lda, sb = (size_t)64 * ldb;
  const int lw = lr * 144 + lc * 16;
  const int aoff = (wm * 128 + r) * 144 + h * 16, boff = 36864 + (wn * 64 + r) * 144 + h * 16;
#pragma unroll
  for (int a = 0; a < 4; ++a)
#pragma unroll
    for (int b = 0; b < 2; ++b)
#pragma unroll
      for (int i = 0; i < 16; ++i) acc[a][b][i] = 0.f;
  uint4 Pa0, Pa1, Pa2, Pa3, Pb0, Pb1, Pb2, Pb3;
#define G256_LOAD(ko) { Pa0 = *(const uint4*)(ga + (ko)); Pa1 = *(const uint4*)(ga + sa + (ko)); Pa2 = *(const uint4*)(ga + 2 * sa + (ko)); Pa3 = *(const uint4*)(ga + 3 * sa + (ko)); \
                        Pb0 = *(const uint4*)(gb + (ko)); Pb1 = *(const uint4*)(gb + sb + (ko)); Pb2 = *(const uint4*)(gb + 2 * sb + (ko)); Pb3 = *(const uint4*)(gb + 3 * sb + (ko)); }
#define G256_STORE(st) { unsigned char* _d = smem + (st) * 73728 + lw; \
    *(uint4*)(_d) = Pa0; *(uint4*)(_d + 64 * 144) = Pa1; *(uint4*)(_d + 128 * 144) = Pa2; *(uint4*)(_d + 192 * 144) = Pa3; \
    *(uint4*)(_d + 36864) = Pb0; *(uint4*)(_d + 36864 + 64 * 144) = Pb1; *(uint4*)(_d + 36864 + 128 * 144) = Pb2; *(uint4*)(_d + 36864 + 192 * 144) = Pb3; }
  G256_LOAD(0)
  G256_STORE(0)
  __syncthreads();
  const int nk = K >> 6;
  for (int kt = 0; kt < nk; ++kt) {
    const bool more = (kt + 1 < nk);
    if (more) G256_LOAD((kt + 1) * 64)
    __builtin_amdgcn_sched_barrier(0);
    const unsigned char* cbuf = smem + (kt & 1) * 73728;
    bf16x8 fb[2][2], fa[2][4];
#define G256_FRAGS(d, s_) { fb[d][0] = *(const bf16x8*)(cbuf + boff + (s_) * 32); fb[d][1] = *(const bf16x8*)(cbuf + boff + 32 * 144 + (s_) * 32); \
      _Pragma("unroll") for (int tm = 0; tm < 4; ++tm) fa[d][tm] = *(const bf16x8*)(cbuf + aoff + tm * 32 * 144 + (s_) * 32); }
    if (G256_DB) G256_FRAGS(0, 0)
#pragma unroll
    for (int s = 0; s < 4; ++s) {
      if (G256_DB) { if (s < 3) G256_FRAGS((s + 1) & 1, s + 1) }
      else G256_FRAGS(0, s)
      __builtin_amdgcn_sched_barrier(0);
      __builtin_amdgcn_s_setprio(2);
#pragma unroll
      for (int tm = 0; tm < 4; ++tm) {
        if (TR) {
          acc[tm][0] = __builtin_amdgcn_mfma_f32_32x32x16_bf16(fb[s & 1][0], fa[s & 1][tm], acc[tm][0], 0, 0, 0);
          acc[tm][1] = __builtin_amdgcn_mfma_f32_32x32x16_bf16(fb[s & 1][1], fa[s & 1][tm], acc[tm][1], 0, 0, 0);
        } else {
          acc[tm][0] = __builtin_amdgcn_mfma_f32_32x32x16_bf16(fa[s & 1][tm], fb[s & 1][0], acc[tm][0], 0, 0, 0);
          acc[tm][1] = __builtin_amdgcn_mfma_f32_32x32x16_bf16(fa[s & 1][tm], fb[s & 1][1], acc[tm][1], 0, 0, 0);
        }
        if (more && s >= 1 && s <= 2) {
          __builtin_amdgcn_sched_barrier(0);
          unsigned char* _d = smem + ((kt + 1) & 1) * 73728 + lw;
          if (s == 1) {
            if (tm == 0) *(uint4*)(_d) = Pa0;
            if (tm == 1) *(uint4*)(_d + 64 * 144) = Pa1;
            if (tm == 2) *(uint4*)(_d + 128 * 144) = Pa2;
            if (tm == 3) *(uint4*)(_d + 192 * 144) = Pa3;
          } else {
            if (tm == 0) *(uint4*)(_d + 36864) = Pb0;
            if (tm == 1) *(uint4*)(_d + 36864 + 64 * 144) = Pb1;
            if (tm == 2) *(uint4*)(_d + 36864 + 128 * 144) = Pb2;
            if (tm == 3) *(uint4*)(_d + 36864 + 192 * 144) = Pb3;
          }
          __builtin_amdgcn_sched_barrier(0);
        }
      }
      __builtin_amdgcn_s_setprio(0);
      __builtin_amdgcn_sched_barrier(0);
    }
#undef G256_FRAGS
    __syncthreads();
  }
#undef G256_LOAD
#undef G256_STORE
}
#define EPI4G(acc, m0, n0, ...)                                                                             \
  {                                                                                                         \
    const int _lane = tidx & 63, _wid = tidx >> 6, _wm = _wid >> 2, _wn = _wid & 3;                         \
    const int _r = _lane & 31, _h = _lane >> 5;                                                             \
    _Pragma("unroll") for (int _tm = 0; _tm < 4; ++_tm) _Pragma("unroll") for (int _tn = 0; _tn < 2; ++_tn) \
    _Pragma("unroll") for (int _g = 0; _g < 4; ++_g) {                                                      \
      const int row = (m0) + _wm * 128 + _tm * 32 + _r;                                                     \
      const int col0 = (n0) + _wn * 64 + _tn * 32 + 8 * _g + 4 * _h;                                        \
      const float v0 = acc[_tm][_tn][4 * _g], v1 = acc[_tm][_tn][4 * _g + 1], v2 = acc[_tm][_tn][4 * _g + 2], v3 = acc[_tm][_tn][4 * _g + 3]; \
      __VA_ARGS__                                                                                           \
    }                                                                                                       \
  }
__device__ __forceinline__ float fsig(float x) { return __builtin_amdgcn_rcpf(1.f + __expf(-x)); }

__device__ __forceinline__ void phase_big_resid(const int tidx, const int vid, unsigned char* smem, const bf16_t* A, int ld, const bf16_t* Bt, int N, int K, const pg8::EpiAll& E) {
  const int wsc = __builtin_amdgcn_readfirstlane(tidx >> 6);
  const int nN = N / 256, nwg = (T / 256) * nN, nig = 8 * nN;
  pg8::Unit u;
  for (int L = vid; L < nwg; L += (int)gridDim.x) {
    { const int gid = L / nig, rem = L % nig; u.pm = gid * 8 + (rem & 7); u.pn = rem >> 3; }
    const int m0 = u.pm * 256, n0 = u.pn * 256;
    f32x16 acc[4][2];
    {
      gemm256_tile<false>(tidx, A, ld, Bt, ld, K, m0, n0, smem, acc);
      int tidr;
    asm volatile("v_mbcnt_lo_u32_b32 %0, -1, 0\n\tv_mbcnt_hi_u32_b32 %0, -1, %0\n\tv_lshl_add_u32 %0, %1, 6, %0" : "=&v"(tidr) : "s"(wsc));
      const float* gb = E.e1.gate + (size_t)(m0 >> 11) * 9216;
      const int _lane = tidr & 63, _wid = tidr >> 6, _wm = _wid >> 2, _wn = _wid & 3, _r = _lane & 31, _h = _lane >> 5;
#pragma unroll
      for (int tn = 0; tn < 2; ++tn) {
        const int col = n0 + _wn * 64 + tn * 32 + _r;
        const float gc = E.e1.coef * gb[col];
#pragma unroll
        for (int tm = 0; tm < 4; ++tm) {
          const float* xs = E.e1.xsrc + (size_t)(m0 + _wm * 128 + tm * 32 + 4 * _h) * 1024 + col;
          float* xd = E.e1.xdst + (size_t)(m0 + _wm * 128 + tm * 32 + 4 * _h) * 1024 + col;
#pragma unroll
          for (int hf = 0; hf < 2; ++hf) {
            float xv[8];
#pragma unroll
            for (int i = 0; i < 8; ++i) xv[i] = xs[((i & 3) + 8 * ((i + 8 * hf) >> 2)) * 1024];
#pragma unroll
            for (int i = 0; i < 8; ++i) xd[((i & 3) + 8 * ((i + 8 * hf) >> 2)) * 1024] = xv[i] + gc * acc[tm][tn][i + 8 * hf];
            asm volatile("" ::: "memory");
          }
        }
      }
    }
  }
}

__device__ __forceinline__ void phase_big(const int tidx, const int vid, unsigned char* smem, const bf16_t* A, int ld, const bf16_t* Bt, int N, int K, const pg8::EpiAll& E) {
  const int wsc = __builtin_amdgcn_readfirstlane(tidx >> 6);
  const int nN = N / 256, nwg = (T / 256) * nN, nig = 8 * nN;
  pg8::Unit u;
  for (int L = vid; L < nwg; L += (int)gridDim.x) {
    { const int gid = L / nig, rem = L % nig; u.pm = gid * 8 + (rem & 7); u.pn = rem >> 3; }
    const int m0 = u.pm * 256, n0 = u.pn * 256;
    f32x16 acc[4][2];
    gemm256_tile<true>(tidx, A, ld, Bt, ld, K, m0, n0, smem, acc);
    int tidr;
    asm volatile("v_mbcnt_lo_u32_b32 %0, -1, 0\n\tv_mbcnt_hi_u32_b32 %0, -1, %0\n\tv_lshl_add_u32 %0, %1, 6, %0" : "=&v"(tidr) : "s"(wsc));
    {
    const int tidx = tidr;
    if (E.mode == 0) {
      const int _lane = tidx & 63, _wid = tidx >> 6, _wm = _wid >> 2, _wn = _wid & 3, _r = _lane & 31, _h = _lane >> 5;
#pragma unroll
      for (int tm = 0; tm < 4; ++tm)
#pragma unroll
        for (int tn = 0; tn < 2; ++tn)
#pragma unroll
          for (int g = 0; g < 2; ++g) {
            const int row = m0 + _wm * 128 + tm * 32 + _r;
            const int hcol = ((n0 + _wn * 64 + tn * 32) >> 1) + 8 * g + 4 * _h;
            const float g0 = acc[tm][tn][4 * g], g1 = acc[tm][tn][4 * g + 1], g2 = acc[tm][tn][4 * g + 2], g3 = acc[tm][tn][4 * g + 3];
            const float u0 = acc[tm][tn][4 * g + 8], u1 = acc[tm][tn][4 * g + 9], u2 = acc[tm][tn][4 * g + 10], u3 = acc[tm][tn][4 * g + 11];
            *(uint2*)(E.e0.ACT + (size_t)row * DFF + hcol) = pack4(g0 * fsig(g0) * u0, g1 * fsig(g1) * u1, g2 * fsig(g2) * u2, g3 * fsig(g3) * u3);
          }
    } else if (E.mode == 2) {
      EPI4G(acc, m0, n0, {
        if (col0 < 1152) *(uint2*)(E.e2.PRKV + (size_t)row * 1152 + col0) = pack4(v0, v1, v2, v3);
        else if (col0 < 1440) { float4 o; o.x = v0; o.y = v1; o.z = v2; o.w = v3; *(float4*)(E.e2.PLORA + (size_t)row * 288 + (col0 - 1152)) = o; }
        else if (col0 < 2592) { const int c2 = col0 - 1440; const float sc = (c2 < 384) ? 0.125f : 1.f; *(uint2*)(E.e2.SBQKV + (size_t)row * 1152 + c2) = pack4(v0 * sc, v1 * sc, v2 * sc, v3 * sc); }
        else if (col0 < 3008) { float4 o; o.x = v0; o.y = v1; o.z = v2; o.w = v3; *(float4*)(E.e2.CQ + (size_t)row * 416 + (col0 - 2592)) = o; }
      })
    } else {
      EPI4G(acc, m0, n0, { *(uint2*)(E.e3.G + (size_t)row * 3072 + col0) = pack4(fsig(v0), fsig(v1), fsig(v2), fsig(v3)); })
    }
    }
  }
}

__device__ __forceinline__ void phase_prep(const int tidx, const Params& p, int l) {
  const float* PLORA = (const float*)(p.ws + WS_PLORA);
  const float* CQ = (const float*)(p.ws + WS_CQ);
  const float* rope = (const float*)(p.ws + WS_ROPE);
  bf16_t* LA = (bf16_t*)(p.ws + WS_LA);
  bf16_t* CQN = (bf16_t*)(p.ws + WS_CQN);
  bf16_t* KROPE = (bf16_t*)(p.ws + WS_KROPE);
  const float* mu = p.in[I_MU] + (size_t)l * 1440 + 1152;
  const float* qg = p.in[I_QNG] + (size_t)l * 256;
  const float* kvg = p.in[I_KVNG] + (size_t)l * 128;
  const int lane = tidx & 63, wid = tidx >> 6;
  for (int row = blockIdx.x * NW + wid; row < T; row += gridDim.x * NW) {
    const bool hasprev = (row & 2047) != 0;
#pragma unroll
    for (int q = 0; q < 5; ++q) {
      const int c = lane + 64 * q;
      float o = 0.f;
      if (c < 288) {
        const float cur = PLORA[(size_t)row * 288 + c];
        const float prev = hasprev ? PLORA[(size_t)(row - 1) * 288 + c] : 0.f;
        const float xs = cur + (prev - cur) * mu[c];
        o = (c < 64) ? tanhf(xs) : ((c < 128) ? xs : sigmoidf_(xs));
      }
      LA[(size_t)row * 320 + c] = f2bf(o);
    }
    float vq[4], vk[2];
    float ssq = 0.f, ssk = 0.f;
#pragma unroll
    for (int q = 0; q < 4; ++q) { vq[q] = CQ[(size_t)row * 416 + lane + 64 * q]; ssq += vq[q] * vq[q]; }
#pragma unroll
    for (int q = 0; q < 2; ++q) { vk[q] = CQ[(size_t)row * 416 + 256 + lane + 64 * q]; ssk += vk[q] * vk[q]; }
    ssq = wave_sum(ssq); ssk = wave_sum(ssk);
    const float rq = rsqrtf(ssq * (1.f / 256.f) + 1e-6f), rk = rsqrtf(ssk * (1.f / 128.f) + 1e-6f);
#pragma unroll
    for (int q = 0; q < 4; ++q) CQN[(size_t)row * 384 + lane + 64 * q] = f2bf(vq[q] * rq * qg[lane + 64 * q]);
#pragma unroll
    for (int q = 0; q < 2; ++q) CQN[(size_t)row * 384 + 256 + lane + 64 * q] = f2bf(vk[q] * rk * kvg[lane + 64 * q]);
    const float kr = (lane < 32) ? CQ[(size_t)row * 416 + 384 + lane] : 0.f;
    const float other = shflx(tidx, kr, 16);
    if (lane < 32) {
      const int i = lane & 15;
      const float cs = rope[(size_t)row * 32 + i], sn = rope[(size_t)row * 32 + 16 + i];
      const float o = (lane < 16) ? (kr * cs - other * sn) : (kr * cs + other * sn);
      KROPE[(size_t)row * 32 + lane] = f2bf(o);
    }
  }
}

__device__ __forceinline__ void phase_small_gemms(const int tidx, const Params& p, int l, unsigned char* smem) {
  const bf16_t* wb = (const bf16_t*)(p.ws + ((l & 1) ? WS_WBF1 : WS_WBF));
  const bf16_t* LA = (const bf16_t*)(p.ws + WS_LA);
  const bf16_t* CQN = (const bf16_t*)(p.ws + WS_CQN);
  const float* rope = (const float*)(p.ws + WS_ROPE);
  float* WL = (float*)(p.ws + WS_WL);
  float* AS = (float*)(p.ws + WS_AS);
  bf16_t* GG = (bf16_t*)(p.ws + WS_GG);
  bf16_t* MLAQ = (bf16_t*)(p.ws + WS_MLAQ);
  bf16_t* MLAKV = (bf16_t*)(p.ws + WS_MLAKV);
  const float* w0 = p.in[I_W0] + (size_t)l * 384;
  const float* a0 = p.in[I_A0] + (size_t)l * 384;
  for (int tile = blockIdx.x; tile < (T / 256) * 20; tile += gridDim.x) {
    const int pm = tile / 20, j = tile % 20, m0 = pm * 256;
    f32x16 acc[2][2];
    if (j < 3) {
      const int n0 = j * 128;
      gemm_mainloop<2>(tidx, LA, 320, wb + WO_W2, 64, 64, m0, n0, smem, acc);
      EPI4(2, acc, m0, n0, {
        const float4 w4 = *(const float4*)(w0 + col0);
        float4 o;
        o.x = -expf(-softplusf_(-(w4.x + v0)) - 0.5f); o.y = -expf(-softplusf_(-(w4.y + v1)) - 0.5f);
        o.z = -expf(-softplusf_(-(w4.z + v2)) - 0.5f); o.w = -expf(-softplusf_(-(w4.w + v3)) - 0.5f);
        *(float4*)(WL + (size_t)row * 384 + col0) = o;
      })
    } else if (j < 6) {
      const int n0 = (j - 3) * 128;
      gemm_mainloop<2>(tidx, LA + 64, 320, wb + WO_A2, 64, 64, m0, n0, smem, acc);
      EPI4(2, acc, m0, n0, {
        const float4 a4 = *(const float4*)(a0 + col0);
        float4 o;
        o.x = sigmoidf_(a4.x + v0); o.y = sigmoidf_(a4.y + v1); o.z = sigmoidf_(a4.z + v2); o.w = sigmoidf_(a4.w + v3);
        *(float4*)(AS + (size_t)row * 384 + col0) = o;
      })
    } else if (j < 9) {
      const int n0 = (j - 6) * 128;
      gemm_mainloop<2>(tidx, LA + 128, 320, wb + WO_G2, 192, 192, m0, n0, smem, acc);
      EPI4(2, acc, m0, n0, { *(uint2*)(GG + (size_t)row * 384 + col0) = pack4(v0, v1, v2, v3); })
    } else if (j < 14) {
      const int n0 = (j - 9) * 128;
      gemm_mainloop<2>(tidx, CQN, 384, wb + WO_UQ, 256, 256, m0, n0, smem, acc);
      EPI4(2, acc, m0, n0, {
        const int cm = col0 % 96;
        float o0 = v0, o1 = v1, o2 = v2, o3 = v3;
        if (cm >= 64) {
          const int ii = (cm - 64) & 15;
          const float4 cs = *(const float4*)(rope + (size_t)row * 32 + ii), sn = *(const float4*)(rope + (size_t)row * 32 + 16 + ii);
          if (cm < 80) { o0 = v0 * cs.x - q0 * sn.x; o1 = v1 * cs.y - q1 * sn.y; o2 = v2 * cs.z - q2 * sn.z; o3 = v3 * cs.w - q3 * sn.w; }
          else { o0 = v0 * cs.x + q0 * sn.x; o1 = v1 * cs.y + q1 * sn.y; o2 = v2 * cs.z + q2 * sn.z; o3 = v3 * cs.w + q3 * sn.w; }
        }
        if (col0 < 576) *(uint2*)(MLAQ + (size_t)row * 576 + col0) = pack4(o0, o1, o2, o3);
      })
    } else {
      const int n0 = (j - 14) * 128;
      gemm_mainloop<2>(tidx, CQN + 256, 384, wb + WO_UKV, 128, 128, m0, n0, smem, acc);
      EPI4(2, acc, m0, n0, { *(uint2*)(MLAKV + (size_t)row * 768 + col0) = pack4(v0, v1, v2, v3); })
    }
  }
}

__device__ __forceinline__ void scan_item(const int tidx, const Params& p, int l, int b, int h, unsigned char* smem) {
  const bf16_t* PRKV = (const bf16_t*)(p.ws + WS_PRKV);
  const float* WL = (const float*)(p.ws + WS_WL);
  const float* AS = (const float*)(p.ws + WS_AS);
  const bf16_t* GG = (const bf16_t*)(p.ws + WS_GG);
  bf16_t* Y = (bf16_t*)(p.ws + WS_Y);
  float* sr = (float*)smem;
  float* sw = sr + 2048;
  float* sk = sw + 2048;
  float* sv = sk + 2048;
  float* sa = sv + 2048;
  float* sb = sa + 2048;
  float* sy = sb + 2048;
  float* sbon = sy + 2048;
  const int tid = tidx, lane = tid & 63, wid = tid >> 6;
  const int hc = h * 64 + lane;
  const float mur = p.in[I_MU][(size_t)l * 1440 + hc], muk = p.in[I_MU][(size_t)l * 1440 + 384 + hc], muv = p.in[I_MU][(size_t)l * 1440 + 768 + hc];
  const float kkc = p.in[I_KK][(size_t)l * 384 + hc], kac = p.in[I_KA][(size_t)l * 384 + hc], rkc = p.in[I_RK][(size_t)l * 384 + hc];
  const float lng = p.in[I_LNG][(size_t)l * 384 + hc], lnb = p.in[I_LNB][(size_t)l * 384 + hc];
  const int rp = (tid & 255) >> 3, g = tid & 7;
  typedef float f32x2 __attribute__((ext_vector_type(2)));
  f32x2 S2[8];
#pragma unroll
  for (int j = 0; j < 8; ++j) S2[j] = (f32x2){0.f, 0.f};
  unsigned short rr[4], rk[4], rv[4], rr1[4], rk1[4], rv1[4], rg[4], rgn[4];
  float rwl[4], ras[4];
#define SCAN_LOAD(t0_) {                                                                             \
    _Pragma("unroll") for (int q = 0; q < 4; ++q) {                                                  \
      const int t = (t0_) + wid * 4 + q;                                                             \
      const size_t row = (size_t)b * SEQ + t;                                                        \
      const bf16_t* pr = PRKV + row * 1152;                                                          \
      rr[q] = pr[hc]; rk[q] = pr[384 + hc]; rv[q] = pr[768 + hc];                                    \
      rr1[q] = 0; rk1[q] = 0; rv1[q] = 0;                                                            \
      if (t > 0) { rr1[q] = *(pr + hc - 1152); rk1[q] = *(pr + 384 + hc - 1152); rv1[q] = *(pr + 768 + hc - 1152); } \
      rwl[q] = WL[row * 384 + hc]; ras[q] = AS[row * 384 + hc]; rgn[q] = GG[row * 384 + hc];        \
    } }
  SCAN_LOAD(0)
  for (int t0 = 0; t0 < SEQ; t0 += 32) {
#pragma unroll
    for (int q = 0; q < 4; ++q) {
      const int tt = wid * 4 + q;
      float r = bf2f(rr[q]), k = bf2f(rk[q]), v = bf2f(rv[q]);
      const float r1 = bf2f(rr1[q]), k1 = bf2f(rk1[q]), v1 = bf2f(rv1[q]);
      r = r + (r1 - r) * mur; k = k + (k1 - k) * muk; v = v + (v1 - v) * muv;
      const float decay = expf(rwl[q]);
      const float as = ras[q];
      const float kkr = k * kkc;
      const float ss = wave_sum(kkr * kkr);
      const float kk = kkr * rsqrtf(fmaxf(ss, 1e-24f));
      const float k2 = k * (1.f + (as - 1.f) * kac);
      const float bon = wave_sum(r * k2 * rkc);
      sr[tt * 64 + lane] = r; sw[tt * 64 + lane] = decay; sk[tt * 64 + lane] = k2; sv[tt * 64 + lane] = v;
      sa[tt * 64 + lane] = -kk; sb[tt * 64 + lane] = kk * as;
      if (lane == 0) sbon[tt] = bon;
      rg[q] = rgn[q];
    }
    __syncthreads();
    if (t0 + 32 < SEQ) SCAN_LOAD(t0 + 32)
    if (wid < 4) {
#pragma unroll 4
      for (int tt = 0; tt < 32; ++tt) {
        const float4* pa = (const float4*)(sa + tt * 64 + g * 8);
        const float4* pw = (const float4*)(sw + tt * 64 + g * 8);
        const float4* pb = (const float4*)(sb + tt * 64 + g * 8);
        const float4* pk = (const float4*)(sk + tt * 64 + g * 8);
        const float4* prr = (const float4*)(sr + tt * 64 + g * 8);
        const float2 vi = *(const float2*)(sv + tt * 64 + 2 * rp);
        float av[8], wv[8], bv[8], kv[8], rv8[8];
#pragma unroll
        for (int q = 0; q < 2; ++q) {
          const float4 a4 = pa[q], w4 = pw[q], b4 = pb[q], k4 = pk[q], r4 = prr[q];
          av[q * 4] = a4.x; av[q * 4 + 1] = a4.y; av[q * 4 + 2] = a4.z; av[q * 4 + 3] = a4.w;
          wv[q * 4] = w4.x; wv[q * 4 + 1] = w4.y; wv[q * 4 + 2] = w4.z; wv[q * 4 + 3] = w4.w;
          bv[q * 4] = b4.x; bv[q * 4 + 1] = b4.y; bv[q * 4 + 2] = b4.z; bv[q * 4 + 3] = b4.w;
          kv[q * 4] = k4.x; kv[q * 4 + 1] = k4.y; kv[q * 4 + 2] = k4.z; kv[q * 4 + 3] = k4.w;
          rv8[q * 4] = r4.x; rv8[q * 4 + 1] = r4.y; rv8[q * 4 + 2] = r4.z; rv8[q * 4 + 3] = r4.w;
        }
        f32x2 sp_a = S2[0] * av[0] + S2[1] * av[1], sp_b = S2[2] * av[2] + S2[3] * av[3], sp_c = S2[4] * av[4] + S2[5] * av[5], sp_d = S2[6] * av[6] + S2[7] * av[7];
        const f32x2 sp = (sp_a + sp_b) + (sp_c + sp_d);
        const float sap0 = sum8(sp.x), sap1 = sum8(sp.y);
        const f32x2 sap2 = (f32x2){sap0, sap1}, vi2 = (f32x2){vi.x, vi.y};
        f32x2 yp_a = (f32x2){0.f, 0.f}, yp_b = (f32x2){0.f, 0.f};
#pragma unroll
        for (int j = 0; j < 8; j += 2) {
          S2[j] = S2[j] * wv[j] + sap2 * bv[j] + vi2 * kv[j];
          S2[j + 1] = S2[j + 1] * wv[j + 1] + sap2 * bv[j + 1] + vi2 * kv[j + 1];
          yp_a += S2[j] * rv8[j];
          yp_b += S2[j + 1] * rv8[j + 1];
        }
        const f32x2 ypv = yp_a + yp_b;
        const float yp0 = sum8(ypv.x), yp1 = sum8(ypv.y);
        if (g == 0) *(float2*)(sy + tt * 64 + 2 * rp) = make_float2(yp0, yp1);
      }
    }
    __syncthreads();
#pragma unroll
    for (int q = 0; q < 4; ++q) {
      const int tt = wid * 4 + q, t = t0 + tt;
      const size_t row = (size_t)b * SEQ + t;
      const float y = sy[tt * 64 + lane];
      const float mean = wave_sum(y) * (1.f / 64.f);
      const float d = y - mean;
      const float var = wave_sum(d * d) * (1.f / 64.f);
      const float yn = d * rsqrtf(var + 64e-5f) * lng + lnb;
      const float gg = bf2f(rg[q]);
      const float o = (yn + sbon[tt] * sv[tt * 64 + lane]) * gg;
      Y[row * 1152 + hc] = f2bf(o);
    }
    __syncthreads();
  }
#undef SCAN_LOAD
}

__device__ __forceinline__ void sb_item(const int tidx, const Params& p, int b, int h, int qb, unsigned char* smem) {
  const bf16_t* QKV = (const bf16_t*)(p.ws + WS_SBQKV);
  bf16_t* Y = (bf16_t*)(p.ws + WS_Y);
  float* Ks = (float*)smem;
  float* Vs = Ks + 4096;
  const int tid = tidx;
  const int t = qb * NT + tid;
  const size_t rowq = (size_t)b * SEQ + t;
  float q[64], o[64];
#pragma unroll
  for (int d = 0; d < 64; d += 8) {
    const uint4 u = *(const uint4*)(QKV + rowq * 1152 + h * 64 + d);
    q[d] = __uint_as_float(u.x << 16); q[d + 1] = __uint_as_float(u.x & 0xffff0000u);
    q[d + 2] = __uint_as_float(u.y << 16); q[d + 3] = __uint_as_float(u.y & 0xffff0000u);
    q[d + 4] = __uint_as_float(u.z << 16); q[d + 5] = __uint_as_float(u.z & 0xffff0000u);
    q[d + 6] = __uint_as_float(u.w << 16); q[d + 7] = __uint_as_float(u.w & 0xffff0000u);
  }
#pragma unroll
  for (int d = 0; d < 64; ++d) o[d] = 0.f;
  float run = 0.f;
  for (int kt = qb * 8 + 7; kt >= 0; --kt) {
    {
      const int kr = tid >> 3, dc = (tid & 7) * 8;
      const bf16_t* src = QKV + ((size_t)b * SEQ + kt * 64 + kr) * 1152 + h * 64 + dc;
#pragma unroll
      for (int e = 0; e < 8; ++e) { Ks[kr * 64 + dc + e] = bf2f(src[384 + e]); Vs[kr * 64 + dc + e] = bf2f(src[768 + e]); }
    }
    __syncthreads();
    for (int sl = 63; sl >= 0; --sl) {
      const int s = kt * 64 + sl;
      if (s < t) {
        const float4* kp = (const float4*)(Ks + sl * 64);
        float z = 0.f;
#pragma unroll
        for (int d4 = 0; d4 < 16; ++d4) { const float4 k4 = kp[d4]; z += q[d4 * 4] * k4.x + q[d4 * 4 + 1] * k4.y + q[d4 * 4 + 2] * k4.z + q[d4 * 4 + 3] * k4.w; }
        const float ln = -softplusf_(z);
        const float w = expf(z + ln + run);
        run += ln;
        const float4* vp = (const float4*)(Vs + sl * 64);
#pragma unroll
        for (int d4 = 0; d4 < 16; ++d4) { const float4 v4 = vp[d4]; o[d4 * 4] += w * v4.x; o[d4 * 4 + 1] += w * v4.y; o[d4 * 4 + 2] += w * v4.z; o[d4 * 4 + 3] += w * v4.w; }
      }
    }
    const bool alive = (run > -120.f);
    int* flag = (int*)(smem + 40960);
    if (tid == 0) *flag = 0;
    __syncthreads();
    if (__builtin_amdgcn_ballot_w64(alive) != 0ull && (tid & 63) == 0) *flag = 1;
    __syncthreads();
    const int any = *flag;
    __syncthreads();
    if (!any) break;
  }
  __syncthreads();
#pragma unroll
  for (int d = 0; d < 64; d += 2) {
    *(unsigned*)(Y + rowq * 1152 + 384 + h * 64 + d) = (unsigned)f2bf(o[d]) | ((unsigned)f2bf(o[d + 1]) << 16);
  }
}

__device__ __forceinline__ void mla_item(const int tidx, const Params& p, int b, int h, int qb, unsigned char* smem) {
  const bf16_t* MQ = (const bf16_t*)(p.ws + WS_MLAQ);
  const bf16_t* MKV = (const bf16_t*)(p.ws + WS_MLAKV);
  const bf16_t* KR = (const bf16_t*)(p.ws + WS_KROPE);
  bf16_t* Y = (bf16_t*)(p.ws + WS_Y);
  float* Ks = (float*)smem;
  float* Vs = Ks + 64 * 96;
  const int tid = tidx;
  const int t = qb * NT + tid;
  const size_t rowq = (size_t)b * SEQ + t;
  unsigned qp[48];
  float o[64];
#pragma unroll
  for (int d = 0; d < 12; ++d) {
    const uint4 u = *(const uint4*)(MQ + rowq * 576 + h * 96 + d * 8);
    qp[d * 4] = u.x; qp[d * 4 + 1] = u.y; qp[d * 4 + 2] = u.z; qp[d * 4 + 3] = u.w;
  }
#pragma unroll
  for (int d = 0; d < 64; ++d) o[d] = 0.f;
  float m = -1e30f, lsum = 0.f;
  for (int kt = 0; kt <= qb * 8 + 7; ++kt) {
    {
      const int kr = tid >> 3, part = tid & 7;
      const size_t rk = (size_t)b * SEQ + kt * 64 + kr;
      const bf16_t* srck = MKV + rk * 768 + h * 128 + part * 8;
      const bf16_t* srcv = srck + 64;
#pragma unroll
      for (int e = 0; e < 8; ++e) { Ks[kr * 96 + part * 8 + e] = bf2f(srck[e]); Vs[kr * 64 + part * 8 + e] = bf2f(srcv[e]); }
      const bf16_t* srcr = KR + rk * 32 + part * 4;
#pragma unroll
      for (int e = 0; e < 4; ++e) Ks[kr * 96 + 64 + part * 4 + e] = bf2f(srcr[e]);
    }
    __syncthreads();
    for (int sl = 0; sl < 64; ++sl) {
      const int s = kt * 64 + sl;
      if (s <= t) {
        const float4* kp = (const float4*)(Ks + sl * 96);
        float z = 0.f;
#pragma unroll
        for (int d4 = 0; d4 < 24; ++d4) { const float4 k4 = kp[d4]; const unsigned qa = qp[d4 * 2], qb2 = qp[d4 * 2 + 1];
          z += __uint_as_float(qa << 16) * k4.x + __uint_as_float(qa & 0xffff0000u) * k4.y + __uint_as_float(qb2 << 16) * k4.z + __uint_as_float(qb2 & 0xffff0000u) * k4.w; }
        if (z > m) {
          const float sc = expf(m - z);
          lsum *= sc;
#pragma unroll
          for (int d = 0; d < 64; ++d) o[d] *= sc;
          m = z;
        }
        const float w = expf(z - m);
        lsum += w;
        const float4* vp = (const float4*)(Vs + sl * 64);
#pragma unroll
        for (int d4 = 0; d4 < 16; ++d4) { const float4 v4 = vp[d4]; o[d4 * 4] += w * v4.x; o[d4 * 4 + 1] += w * v4.y; o[d4 * 4 + 2] += w * v4.z; o[d4 * 4 + 3] += w * v4.w; }
      }
    }
    __syncthreads();
  }
  const float inv = 1.f / lsum;
#pragma unroll
  for (int d = 0; d < 64; d += 2) {
    *(unsigned*)(Y + rowq * 1152 + 768 + h * 64 + d) = (unsigned)f2bf(o[d] * inv) | ((unsigned)f2bf(o[d + 1] * inv) << 16);
  }
}

__device__ __forceinline__ void mla_mfma_item(const int tidx, const Params& p, int b, int h, int qb, unsigned char* smem) {
  const bf16_t* MQ = (const bf16_t*)(p.ws + WS_MLAQ);
  const bf16_t* MKV = (const bf16_t*)(p.ws + WS_MLAKV);
  const bf16_t* KR = (const bf16_t*)(p.ws + WS_KROPE);
  bf16_t* Y = (bf16_t*)(p.ws + WS_Y);
  const int tid = tidx, lane = tid & 63, wid = tid >> 6, r = lane & 31, hh = lane >> 5;
  const int qw0 = qb * 256 + wid * 32;
  const size_t rowq = (size_t)b * SEQ + qw0 + r;
  bf16x8 qf[6];
#pragma unroll
  for (int s = 0; s < 6; ++s) qf[s] = *(const bf16x8*)(MQ + rowq * 576 + h * 96 + s * 16 + 8 * hh);
  f32x16 o[2];
#pragma unroll
  for (int i = 0; i < 16; ++i) { o[0][i] = 0.f; o[1][i] = 0.f; }
  float m = -1e30f, l = 0.f;
  const int ntiles = 4 * (qb + 1);
  const int skey = tid >> 3, sdc = tid & 7, rkey = (tid & 255) >> 2, rdc = tid & 3;
  const bf16_t* gk = MKV + ((size_t)b * SEQ + skey) * 768 + h * 128 + sdc * 8;
  const bf16_t* gr = KR + ((size_t)b * SEQ + rkey) * 32 + rdc * 8;
  uint4 kn = *(const uint4*)gk, vv = *(const uint4*)(gk + 64), kr4 = make_uint4(0, 0, 0, 0);
  if (tid < 256) kr4 = *(const uint4*)gr;
#define MLA_STORE(bufi) {                                                                             \
    unsigned char* _b = smem + (bufi) * 22016;                                                        \
    *(uint4*)(_b + skey * 208 + sdc * 16) = kn;                                                       \
    if (tid < 256) *(uint4*)(_b + rkey * 208 + 128 + rdc * 16) = kr4;                                 \
    unsigned short* _vt = (unsigned short*)(_b + 13312) + skey;                                       \
    const int _d0 = sdc * 8;                                                                          \
    _vt[(_d0 + 0) * 68] = (unsigned short)(vv.x & 0xffffu); _vt[(_d0 + 1) * 68] = (unsigned short)(vv.x >> 16); \
    _vt[(_d0 + 2) * 68] = (unsigned short)(vv.y & 0xffffu); _vt[(_d0 + 3) * 68] = (unsigned short)(vv.y >> 16); \
    _vt[(_d0 + 4) * 68] = (unsigned short)(vv.z & 0xffffu); _vt[(_d0 + 5) * 68] = (unsigned short)(vv.z >> 16); \
    _vt[(_d0 + 6) * 68] = (unsigned short)(vv.w & 0xffffu); _vt[(_d0 + 7) * 68] = (unsigned short)(vv.w >> 16); }
  MLA_STORE(0)
  __syncthreads();
  for (int kt = 0; kt < ntiles; ++kt) {
    if (kt + 1 < ntiles) {
      const size_t ko = (size_t)(kt + 1) * 64;
      kn = *(const uint4*)(gk + ko * 768); vv = *(const uint4*)(gk + ko * 768 + 64);
      if (tid < 256) kr4 = *(const uint4*)(gr + ko * 32);
    }
    if (kt * 64 <= qw0 + 31) {
      const unsigned char* Ks = smem + (kt & 1) * 22016;
      const unsigned char* Vt = Ks + 13312;
      f32x16 st[2];
#pragma unroll
      for (int kb = 0; kb < 2; ++kb) {
#pragma unroll
        for (int i = 0; i < 16; ++i) st[kb][i] = 0.f;
#pragma unroll
        for (int s = 0; s < 6; ++s) {
          const bf16x8 a = *(const bf16x8*)(Ks + (kb * 32 + r) * 208 + s * 32 + hh * 16);
          st[kb] = __builtin_amdgcn_mfma_f32_32x32x16_bf16(a, qf[s], st[kb], 0, 0, 0);
        }
      }
      if (kt * 64 + 63 > qw0) {
        const int qpos = qw0 + r;
#pragma unroll
        for (int kb = 0; kb < 2; ++kb)
#pragma unroll
          for (int i = 0; i < 16; ++i) {
            const int kpos = kt * 64 + kb * 32 + (i & 3) + 8 * (i >> 2) + 4 * hh;
            if (kpos > qpos) st[kb][i] = -1e30f;
          }
      }
      float mx = -1e30f;
#pragma unroll
      for (int kb = 0; kb < 2; ++kb)
#pragma unroll
        for (int i = 0; i < 16; ++i) mx = fmaxf(mx, st[kb][i]);
      mx = fmaxf(mx, shflx(tidx, mx, 32));
      const float mnew = fmaxf(m, mx);
      const float sc = __expf(m - mnew);
      m = mnew;
      float psum = 0.f;
#pragma unroll
      for (int kb = 0; kb < 2; ++kb)
#pragma unroll
        for (int i = 0; i < 16; ++i) { const float pv = __expf(st[kb][i] - mnew); st[kb][i] = pv; psum += pv; }
      psum += shflx(tidx, psum, 32);
      l = l * sc + psum;
#pragma unroll
      for (int i = 0; i < 16; ++i) { o[0][i] *= sc; o[1][i] *= sc; }
#pragma unroll
      for (int kb = 0; kb < 2; ++kb)
#pragma unroll
        for (int s2 = 0; s2 < 2; ++s2) {
          union { unsigned u[4]; bf16x8 v; } pk;
#pragma unroll
          for (int j = 0; j < 4; ++j) pk.u[j] = (unsigned)f2bf(st[kb][8 * s2 + 2 * j]) | ((unsigned)f2bf(st[kb][8 * s2 + 2 * j + 1]) << 16);
#pragma unroll
          for (int db = 0; db < 2; ++db) {
            const unsigned char* vp = Vt + (db * 32 + r) * 136 + (kb * 32 + 16 * s2 + 4 * hh) * 2;
            union { uint2 q2[2]; bf16x8 v; } va;
            va.q2[0] = *(const uint2*)vp; va.q2[1] = *(const uint2*)(vp + 16);
            o[db] = __builtin_amdgcn_mfma_f32_32x32x16_bf16(va.v, pk.v, o[db], 0, 0, 0);
          }
        }
    }
    if (kt + 1 < ntiles) MLA_STORE((kt + 1) & 1)
    __syncthreads();
  }
#undef MLA_STORE
  const float inv = 1.f / l;
#pragma unroll
  for (int db = 0; db < 2; ++db)
#pragma unroll
    for (int g = 0; g < 4; ++g) {
      const int d0 = db * 32 + 8 * g + 4 * hh;
      *(uint2*)(Y + rowq * 1152 + 768 + h * 64 + d0) = pack4(o[db][4 * g] * inv, o[db][4 * g + 1] * inv, o[db][4 * g + 2] * inv, o[db][4 * g + 3] * inv);
    }
}

__device__ __forceinline__ void sb_mfma_item(const int tidx, const Params& p, int b, int h, int qb, unsigned char* smem) {
  const bf16_t* QKV = (const bf16_t*)(p.ws + WS_SBQKV);
  bf16_t* Y = (bf16_t*)(p.ws + WS_Y);
  const int tid = tidx, lane = tid & 63, wid = tid >> 6, r = lane & 31, hh = lane >> 5;
  const int qw0 = qb * 256 + wid * 32;
  const int tq = qw0 + r;
  const size_t rowq = (size_t)b * SEQ + tq;
  bf16x8 qf[4];
#pragma unroll
  for (int s = 0; s < 4; ++s) qf[s] = *(const bf16x8*)(QKV + rowq * 1152 + h * 64 + s * 16 + 8 * hh);
  f32x16 o[2];
#pragma unroll
  for (int i = 0; i < 16; ++i) { o[0][i] = 0.f; o[1][i] = 0.f; }
  float run = 0.f;
  int* fl = (int*)(smem + 36864);
  const int skey = tid >> 3, sdc = tid & 7;
  const int ktmax = 4 * qb + 3;
  const bf16_t* gk = QKV + ((size_t)b * SEQ + skey) * 1152 + 384 + h * 64 + sdc * 8;
  uint4 kn = *(const uint4*)(gk + (size_t)ktmax * 64 * 1152), vv = *(const uint4*)(gk + (size_t)ktmax * 64 * 1152 + 384);
#define SB_STORE(bufi) {                                                                              \
    unsigned char* _b = smem + (bufi) * 17920;                                                        \
    *(uint4*)(_b + skey * 144 + sdc * 16) = kn;                                                       \
    unsigned short* _vt = (unsigned short*)(_b + 9216) + skey;                                        \
    const int _d0 = sdc * 8;                                                                          \
    _vt[(_d0 + 0) * 68] = (unsigned short)(vv.x & 0xffffu); _vt[(_d0 + 1) * 68] = (unsigned short)(vv.x >> 16); \
    _vt[(_d0 + 2) * 68] = (unsigned short)(vv.y & 0xffffu); _vt[(_d0 + 3) * 68] = (unsigned short)(vv.y >> 16); \
    _vt[(_d0 + 4) * 68] = (unsigned short)(vv.z & 0xffffu); _vt[(_d0 + 5) * 68] = (unsigned short)(vv.z >> 16); \
    _vt[(_d0 + 6) * 68] = (unsigned short)(vv.w & 0xffffu); _vt[(_d0 + 7) * 68] = (unsigned short)(vv.w >> 16); }
  SB_STORE(ktmax & 1)
  __syncthreads();
  for (int kt = ktmax; kt >= 0; --kt) {
    if (kt > 0) { const size_t ko = (size_t)(kt - 1) * 64 * 1152; kn = *(const uint4*)(gk + ko); vv = *(const uint4*)(gk + ko + 384); }
    const bool walive = __builtin_amdgcn_ballot_w64(run > -120.f) != 0ull;
    if (walive && kt * 64 <= qw0 + 30) {
      const unsigned char* Ks = smem + (kt & 1) * 17920;
      const unsigned char* Vt = Ks + 9216;
      f32x16 st[2];
#pragma unroll
      for (int kb = 0; kb < 2; ++kb) {
#pragma unroll
        for (int i = 0; i < 16; ++i) st[kb][i] = 0.f;
#pragma unroll
        for (int s = 0; s < 4; ++s) {
          const bf16x8 a = *(const bf16x8*)(Ks + (kb * 32 + r) * 144 + s * 32 + hh * 16);
          st[kb] = __builtin_amdgcn_mfma_f32_32x32x16_bf16(a, qf[s], st[kb], 0, 0, 0);
        }
      }
      const bool diag = (kt * 64 + 63 >= qw0);
      float ln[2][16], G[8];
#pragma unroll
      for (int kb = 0; kb < 2; ++kb)
#pragma unroll
        for (int g = 0; g < 4; ++g) {
          float gs = 0.f;
#pragma unroll
          for (int j = 0; j < 4; ++j) {
            const int i = 4 * g + j;
            const float z = st[kb][i];
            float v = -(fmaxf(z, 0.f) + __logf(1.f + __expf(-fabsf(z))));
            if (diag) { const int kpos = kt * 64 + kb * 32 + 8 * g + 4 * hh + j; if (kpos >= tq) v = 0.f; }
            ln[kb][i] = v; gs += v;
          }
          G[kb * 4 + g] = gs;
        }
      float Gp[8];
#pragma unroll
      for (int q = 0; q < 8; ++q) Gp[q] = shflx(tidx, G[q], 32);
      float aft[8];
      {
        float acc_o = 0.f, acc_p = 0.f;
#pragma unroll
        for (int q = 7; q >= 0; --q) {
          aft[q] = acc_o + acc_p + (hh == 0 ? Gp[q] : 0.f);
          acc_o += G[q]; acc_p += Gp[q];
        }
#pragma unroll
        for (int kb = 0; kb < 2; ++kb)
#pragma unroll
          for (int g = 0; g < 4; ++g) {
            float a3 = run + aft[kb * 4 + g];
#pragma unroll
            for (int j = 3; j >= 0; --j) {
              const int i = 4 * g + j;
              const float z = st[kb][i], l1 = ln[kb][i];
              float w = __expf(z + l1 + a3);
              if (diag) { const int kpos = kt * 64 + kb * 32 + 8 * g + 4 * hh + j; if (kpos >= tq) w = 0.f; }
              st[kb][i] = w;
              a3 += l1;
            }
          }
        run += acc_o + acc_p;
      }
#pragma unroll
      for (int kb = 0; kb < 2; ++kb)
#pragma unroll
        for (int s2 = 0; s2 < 2; ++s2) {
          union { unsigned u[4]; bf16x8 v; } pk;
#pragma unroll
          for (int j = 0; j < 4; ++j) pk.u[j] = (unsigned)f2bf(st[kb][8 * s2 + 2 * j]) | ((unsigned)f2bf(st[kb][8 * s2 + 2 * j + 1]) << 16);
#pragma unroll
          for (int db = 0; db < 2; ++db) {
            const unsigned char* vp = Vt + (db * 32 + r) * 136 + (kb * 32 + 16 * s2 + 4 * hh) * 2;
            union { uint2 q2[2]; bf16x8 v; } va;
            va.q2[0] = *(const uint2*)vp; va.q2[1] = *(const uint2*)(vp + 16);
            o[db] = __builtin_amdgcn_mfma_f32_32x32x16_bf16(va.v, pk.v, o[db], 0, 0, 0);
          }
        }
    }
    if (kt > 0) SB_STORE((kt - 1) & 1)
    const bool walive2 = __builtin_amdgcn_ballot_w64(run > -120.f) != 0ull;
    if (lane == 0) fl[(kt & 1) * 8 + wid] = walive2 ? 1 : 0;
    __syncthreads();
    int any = 0;
#pragma unroll
    for (int q = 0; q < 8; ++q) any |= fl[(kt & 1) * 8 + q];
    if (!any) break;
  }
#undef SB_STORE
  __syncthreads();
#pragma unroll
  for (int db = 0; db < 2; ++db)
#pragma unroll
    for (int g = 0; g < 4; ++g) {
      const int d0 = db * 32 + 8 * g + 4 * hh;
      *(uint2*)(Y + rowq * 1152 + 384 + h * 64 + d0) = pack4(o[db][4 * g], o[db][4 * g + 1], o[db][4 * g + 2], o[db][4 * g + 3]);
    }
}

__device__ __forceinline__ void phase_mixers(const int tidx, const Params& p, int l, unsigned char* smem) {
  volatile int* s_item_p = (volatile int*)(smem + 147440);
  unsigned* ctr = (unsigned*)(p.ws + WS_CTL) + 64 * l;
  for (;;) {
    if (tidx == 0) *s_item_p = (int)atomicAdd(ctr, 1u);
    __syncthreads();
    const int it = *s_item_p;
    __syncthreads();
    if (it >= 96 + 768 + 768) break;
    if (it < 96) {
#ifndef NO_SCAN
      scan_item(tidx, p, l, it / 6, it % 6, smem);
#endif
    } else {
      const int j = it - 96;
      if (j < 768) { const int qb = 7 - j / 96, jj = j % 96; mla_mfma_item(tidx, p, jj / 6, jj % 6, qb, smem); }
      else { const int j2 = j - 768, qb = 7 - j2 / 96, jj = j2 % 96; sb_mfma_item(tidx, p, jj / 6, jj % 6, qb, smem); }
    }
    __syncthreads();
  }
}

__device__ __forceinline__ void phase_merge(const int tidx, const Params& p, int l, unsigned char* smem) {
  const bf16_t* wb = (const bf16_t*)(p.ws + ((l & 1) ? WS_WBF1 : WS_WBF));
  const bf16_t* Y = (const bf16_t*)(p.ws + WS_Y);
  const bf16_t* GT = (const bf16_t*)(p.ws + WS_GATES);
  bf16_t* MG = (bf16_t*)(p.ws + WS_MERGED);
  constexpr int NTN = 8;
  for (int tile = blockIdx.x; tile < (T / 256) * NTN; tile += gridDim.x) {
    const int pm = tile / NTN, pn = tile % NTN, m0 = pm * 256, n0 = pn * 128;
    f32x16 tot[2][2];
#pragma unroll
    for (int a = 0; a < 2; ++a)
#pragma unroll
      for (int b = 0; b < 2; ++b)
#pragma unroll
        for (int i = 0; i < 16; ++i) tot[a][b][i] = 0.f;
#pragma unroll 1
    for (int n = 0; n < 3; ++n) {
      f32x16 acc[2][2];
      const bf16_t* gp = GT + n * 1024;
      uint2 gv[2][2][4];
      {
        const int _lane = tidx & 63, _wid = tidx >> 6, _wm = _wid >> 1, _wn = _wid & 1, _r = _lane & 31, _h = _lane >> 5;
#pragma unroll
        for (int a = 0; a < 2; ++a)
#pragma unroll
          for (int b = 0; b < 2; ++b)
#pragma unroll
            for (int g = 0; g < 4; ++g)
              gv[a][b][g] = *(const uint2*)(gp + (size_t)(m0 + _wm * 64 + a * 32 + _r) * 3072 + (n0 + _wn * 64 + b * 32 + 8 * g + 4 * _h));
      }
      __builtin_amdgcn_sched_barrier(0);
      gemm_mainloop<2>(tidx, Y + n * 384, 1152, wb + WO_BW + (size_t)n * 1024 * 384, 384, 384, m0, n0, smem, acc);
      {
#pragma unroll
        for (int a = 0; a < 2; ++a)
#pragma unroll
          for (int b = 0; b < 2; ++b)
#pragma unroll
            for (int g = 0; g < 4; ++g) {
              const uint2 u = gv[a][b][g];
              tot[a][b][4 * g] += __uint_as_float(u.x << 16) * acc[a][b][4 * g];
              tot[a][b][4 * g + 1] += __uint_as_float(u.x & 0xffff0000u) * acc[a][b][4 * g + 1];
              tot[a][b][4 * g + 2] += __uint_as_float(u.y << 16) * acc[a][b][4 * g + 2];
              tot[a][b][4 * g + 3] += __uint_as_float(u.y & 0xffff0000u) * acc[a][b][4 * g + 3];
            }
      }
    }
    EPI4(2, tot, m0, n0, { *(uint2*)(MG + (size_t)row * 1024 + col0) = pack4(v0, v1, v2, v3); })
  }
}

__device__ __forceinline__ void phase_final(const int tidx, const Params& p) {
  const float* g = p.in[I_FING];
  float* X = p.out;
  const int lane = tidx & 63, wid = tidx >> 6;
  for (int row = blockIdx.x * NW + wid; row < T; row += gridDim.x * NW) {
    float* xr = X + (size_t)row * 1024;
    float4 v[4];
    float ss = 0.f;
#pragma unroll
    for (int q = 0; q < 4; ++q) {
      v[q] = *(const float4*)(xr + q * 256 + lane * 4);
      ss += v[q].x * v[q].x + v[q].y * v[q].y + v[q].z * v[q].z + v[q].w * v[q].w;
    }
    ss = wave_sum(ss);
    const float rstd = rsqrtf(ss * (1.f / 1024.f) + 1e-6f);
#pragma unroll
    for (int q = 0; q < 4; ++q) {
      const int c0 = q * 256 + lane * 4;
      const float4 gg = *(const float4*)(g + c0);
      float4 o;
      o.x = v[q].x * rstd * gg.x; o.y = v[q].y * rstd * gg.y; o.z = v[q].z * rstd * gg.z; o.w = v[q].w * rstd * gg.w;
      *(float4*)(xr + c0) = o;
    }
  }
}

__global__ void __launch_bounds__(NT, 2) mega(Params p) {
  extern __shared__ __attribute__((aligned(16))) unsigned char smem[];
#ifdef EXP_ZERO
  {
    const int t0 = hipThreadIdx_x;
    for (int i = t0; i < LDS_BYTES / 16; i += NT) ((uint4*)smem)[i] = make_uint4(0, 0, 0, 0);
    uint4* wz = (uint4*)(p.ws + WS_WBF);
    const size_t n16 = (WS_END - WS_WBF) / 16;
    for (size_t i = (size_t)hipBlockIdx_x * NT + t0; i < n16; i += (size_t)hipGridDim_x * NT) wz[i] = make_uint4(0, 0, 0, 0);
    __syncthreads();
  }
#endif
  const unsigned xcc = (unsigned)__builtin_amdgcn_s_getreg((3 << 11) | 20) & 0xFu;
  unsigned* xcnt = (unsigned*)(p.ws + WS_CTL) + 8192;
  if (hipThreadIdx_x == 0) ((volatile int*)smem)[0] = (int)__hip_atomic_fetch_add(xcnt + 32 * xcc, 1u, __ATOMIC_RELAXED, __HIP_MEMORY_SCOPE_AGENT);
  cg::this_grid().sync();
  if (hipThreadIdx_x == 0) {
    int base = 0;
    for (unsigned x = 0; x < xcc; ++x) base += (int)__hip_atomic_load(xcnt + 32 * x, __ATOMIC_RELAXED, __HIP_MEMORY_SCOPE_AGENT);
    ((volatile int*)smem)[0] += base;
  }
  __syncthreads();
  const int vid = __builtin_amdgcn_readfirstlane(((volatile int*)smem)[0]);
  __syncthreads();
  const int wave_id = __builtin_amdgcn_readfirstlane((int)hipThreadIdx_x >> 6);
  for (int ph = p.ph_lo; ph < p.ph_hi; ++ph) {
    int tidx;
    asm volatile("v_mbcnt_lo_u32_b32 %0, -1, 0\n\tv_mbcnt_hi_u32_b32 %0, -1, %0\n\tv_lshl_add_u32 %0, %1, 6, %0" : "=&v"(tidx) : "s"(wave_id));
    {
      unsigned long long wsv = (unsigned long long)p.ws;
      asm volatile("" : "+s"(wsv));
      p.ws = (unsigned char*)(__attribute__((address_space(1))) unsigned char*)wsv;
    }
    const bf16_t* wb0 = (const bf16_t*)(p.ws + WS_WBF);
    const float* modall = (const float*)(p.ws + WS_MOD);
    if (ph == 0) {
      phase_mod(tidx, p, smem);
      phase_rope(tidx, p);
      convert_layer(tidx, p, 0, smem);
    } else if (ph == NPH - 1) {
      phase_final(tidx, p);
    } else {
      const int l = (ph - 1) / NPH_LAYER, s = (ph - 1) % NPH_LAYER;
      const bf16_t* wb = (l & 1) ? (const bf16_t*)(p.ws + WS_WBF1) : wb0;
      const float* modl = modall + (size_t)l * 16 * 9216;
      const float* xcur = (l == 0 && s <= 2) ? p.in[I_X] : p.out;
      const bf16_t* Hb = (const bf16_t*)(p.ws + WS_H);
      pg8::EpiAll E;
      E.mode = -1;
      const bf16_t* gA = Hb; const bf16_t* gB = wb; int gld = 1024, gN = 1024, gK = 1024;
      bf16_t* ACTp = (bf16_t*)(p.ws + WS_ACT);
      E.e0.ACT = ACTp;
      E.e1.xsrc = p.out; E.e1.xdst = p.out; E.e1.gate = modl; E.e1.coef = 0.5f;
      E.e2.PRKV = (bf16_t*)(p.ws + WS_PRKV); E.e2.PLORA = (float*)(p.ws + WS_PLORA); E.e2.SBQKV = (bf16_t*)(p.ws + WS_SBQKV); E.e2.CQ = (float*)(p.ws + WS_CQ);
      E.e3.G = (bf16_t*)(p.ws + WS_GATES);
      switch (s) {
        case 0:
          phase_modnorm(tidx, p, l, 0, xcur);
          break;
        case 1: E.mode = 0; gB = wb + WO_W1IN; gN = 5632; break;
        case 2: E.mode = 1; E.e1.xsrc = xcur; E.e1.gate = modl + 0 * 3072 + 2048; gA = ACTp; gB = wb + WO_W1OUT; gld = DFF; gK = DFF; break;
        case 3: phase_modnorm(tidx, p, l, 1, p.out); break;
        case 4: E.mode = 2; gB = wb + WO_WIN; gN = 3072; break;
        case 5: phase_prep(tidx, p, l); break;
#ifndef NO_SMALL
        case 6: phase_small_gemms(tidx, p, l, smem); break;
#endif
#ifndef NO_MIX
        case 7:
          phase_mixers(tidx, p, l, smem);
          if (l + 1 < DEPTH) convert_layer(tidx, p, l + 1, smem);
          break;
#endif
        case 8: E.mode = 3; gB = wb + WO_WG; gN = 3072; break;
#ifndef NO_MERGE
        case 9: phase_merge(tidx, p, l, smem); break;
#endif
        case 10: E.mode = 1; E.e1.gate = modl + 1 * 3072 + 2048; E.e1.coef = 1.0f; gA = (const bf16_t*)(p.ws + WS_MERGED); gB = wb + WO_WOUT; break;
        case 11: phase_modnorm(tidx, p, l, 2, p.out); break;
        case 12: E.mode = 0; gB = wb + WO_W2IN; gN = 5632; break;
        case 13: E.mode = 1; E.e1.gate = modl + 2 * 3072 + 2048; gA = ACTp; gB = wb + WO_W2OUT; gld = DFF; gK = DFF; break;
      }
#ifndef NO_PG8
      if (E.mode == 1) phase_big_resid(tidx, vid, smem, gA, gld, gB, gN, gK, E);
      else if (E.mode >= 0) phase_big(tidx, vid, smem, gA, gld, gB, gN, gK, E);
#endif
    }
    if (ph + 1 < p.ph_hi) {
      unsigned* bar = (unsigned*)(p.ws + WS_CTL) + 1024 + 32 * ph;
      asm volatile("s_waitcnt vmcnt(0) lgkmcnt(0)" ::: "memory");
      __syncthreads();
      if (tidx == 0) {
        __builtin_amdgcn_fence(__ATOMIC_RELEASE, "agent");
        asm volatile("s_waitcnt vmcnt(0)" ::: "memory");
        __hip_atomic_fetch_add(bar, 1u, __ATOMIC_RELAXED, __HIP_MEMORY_SCOPE_AGENT);
        while (__hip_atomic_load(bar, __ATOMIC_RELAXED, __HIP_MEMORY_SCOPE_AGENT) < gridDim.x) __builtin_amdgcn_s_sleep(2);
        __builtin_amdgcn_fence(__ATOMIC_ACQUIRE, "agent");
        asm volatile("s_waitcnt vmcnt(0)" ::: "memory");
      }
      __syncthreads();
    }
  }
}

extern "C" void kernel_launch(void* const* d_in, const int* in_sizes, int n_in, void* d_out, int out_size,
                              void* d_ws, size_t ws_size, hipStream_t stream) {
  static int grid_blocks = 0;
  if (!grid_blocks) {
    int dev = 0, cus = 0, per_cu = 0;
    (void)hipGetDevice(&dev);
    (void)hipDeviceGetAttribute(&cus, hipDeviceAttributeMultiprocessorCount, dev);
    if (hipFuncSetAttribute((const void*)mega, hipFuncAttributeMaxDynamicSharedMemorySize, LDS_BYTES) != hipSuccess)
      fprintf(stderr, "hipFuncSetAttribute(max dynamic LDS) failed\n");
    (void)hipOccupancyMaxActiveBlocksPerMultiprocessor(&per_cu, mega, NT, LDS_BYTES);
    if (per_cu < 1) fprintf(stderr, "occupancy query says %d blocks/CU\n", per_cu);
    grid_blocks = cus;
    if (ws_size < WS_END) fprintf(stderr, "ws too small: %zu < %zu\n", ws_size, (size_t)WS_END);
    (void)hipGetLastError();
  }
  Params p;
  memset(&p, 0, sizeof p);
  for (int i = 0; i < 29; ++i) p.in[i] = (const float*)d_in[i];
  p.out = (float*)d_out;
  p.ws = (unsigned char*)d_ws;
  p.ph_lo = 0; p.ph_hi = NPH;
  (void)hipMemsetAsync(d_ws, 0, 4 * MiB, stream);
  void* args[] = {&p};
  hipError_t e = hipLaunchCooperativeKernel((void*)mega, dim3(grid_blocks), dim3(NT), args, LDS_BYTES, stream);
  if (e != hipSuccess) fprintf(stderr, "coop launch failed: %s\n", hipGetErrorString(e));
}
```

```cpp
#include <hip/hip_runtime.h>
#include <hip/hip_cooperative_groups.h>
#include <cstdio>
#include <cstring>
namespace cg = cooperative_groups;

typedef unsigned short bf16_t;
using bf16x8 = __attribute__((ext_vector_type(8))) short;
using f32x16 = __attribute__((ext_vector_type(16))) float;

constexpr int T = 32768, DM = 1024, NB = 16, SEQ = 2048, DEPTH = 4, DFF = 2816;
constexpr int NPH_LAYER = 14, NPH = 1 + NPH_LAYER * DEPTH + 1;
constexpr int NT = 512, NW = 8, LDS_BYTES = 147456;
constexpr size_t MiB = 1u << 20;
constexpr size_t WS_CTL = 0, WS_MOD = 1 * MiB, WS_ROPE = 4 * MiB, WS_WBF = 8 * MiB, WS_H = 60 * MiB, WS_R = 124 * MiB;
constexpr size_t WS_ACT = WS_R;
constexpr size_t WS_PRKV = WS_R;
constexpr size_t WS_SBQKV = WS_R + 72 * MiB;
constexpr size_t WS_MERGED = WS_SBQKV;
constexpr size_t WS_PLORA = WS_R + 144 * MiB;
constexpr size_t WS_CQ = WS_R + 180 * MiB;
constexpr size_t WS_Y = WS_PLORA;
constexpr size_t WS_LA = WS_R + 232 * MiB;
constexpr size_t WS_CQN = WS_R + 252 * MiB;
constexpr size_t WS_KROPE = WS_R + 276 * MiB;
constexpr size_t WS_MLAQ = WS_R + 278 * MiB;
constexpr size_t WS_MLAKV = WS_R + 314 * MiB;
constexpr size_t WS_WL = WS_R + 362 * MiB;
constexpr size_t WS_AS = WS_R + 410 * MiB;
constexpr size_t WS_GG = WS_R + 458 * MiB;
constexpr size_t WS_GATES = WS_R + 232 * MiB;
constexpr size_t WS_WBF1 = WS_R + 482 * MiB;
constexpr size_t WS_END = WS_WBF1 + 52 * MiB;
constexpr size_t WO_W1IN = 0, WO_W1OUT = WO_W1IN + 5632 * 1024, WO_WIN = WO_W1OUT + 1024 * 2816, WO_WG = WO_WIN + 3072 * 1024,
                 WO_W2 = WO_WG + 3072 * 1024, WO_A2 = WO_W2 + 384 * 64, WO_G2 = WO_A2 + 384 * 64, WO_UQ = WO_G2 + 384 * 192,
                 WO_UKV = WO_UQ + 640 * 256, WO_BW = WO_UKV + 768 * 128, WO_WOUT = WO_BW + 3 * 1024 * 384,
                 WO_W2IN = WO_WOUT + 1024 * 1024, WO_W2OUT = WO_W2IN + 5632 * 1024, WO_END = WO_W2OUT + 1024 * 2816;
static_assert(WO_END * 2 <= 52 * MiB, "wbf");

struct Params {
  const float* in[29];
  float* out;
  unsigned char* ws;
  int ph_lo, ph_hi;
};
enum { I_X = 0, I_C, I_POS, I_ADAW, I_ADAB, I_NORMG, I_F1IN, I_F1OUT, I_MIXIN, I_MU, I_W0, I_W2, I_A0, I_A2, I_G2, I_KK, I_KA, I_RK,
       I_LNG, I_LNB, I_QNG, I_UQ, I_KVNG, I_UKV, I_BW, I_MIXOUT, I_F2IN, I_F2OUT, I_FING };

__device__ __forceinline__ unsigned short f2bf(float f) { unsigned u = __float_as_uint(f); u += 0x7fffu + ((u >> 16) & 1u); return (unsigned short)(u >> 16); }
__device__ __forceinline__ float bf2f(unsigned short b) { return __uint_as_float(((unsigned)b) << 16); }
template <int CTRL> __device__ __forceinline__ float dpp_f(float v) {
  return __builtin_bit_cast(float, __builtin_amdgcn_update_dpp(0, __builtin_bit_cast(int, v), CTRL, 0xF, 0xF, true));
}
__device__ __forceinline__ float sum8(float v) { v += dpp_f<0xB1>(v); v += dpp_f<0x4E>(v); v += dpp_f<0x141>(v); return v; }
__device__ __forceinline__ float wave_sum(float v) {
  v = sum8(v); v += dpp_f<0x140>(v);
  return (__builtin_bit_cast(float, __builtin_amdgcn_readlane(__builtin_bit_cast(int, v), 0)) + __builtin_bit_cast(float, __builtin_amdgcn_readlane(__builtin_bit_cast(int, v), 16)))
       + (__builtin_bit_cast(float, __builtin_amdgcn_readlane(__builtin_bit_cast(int, v), 32)) + __builtin_bit_cast(float, __builtin_amdgcn_readlane(__builtin_bit_cast(int, v), 48)));
}
__device__ __forceinline__ float shflx(const int tidx, float v, int mask) {
  return __builtin_bit_cast(float, __builtin_amdgcn_ds_bpermute(((tidx ^ mask) & 63) << 2, __builtin_bit_cast(int, v)));
}
__device__ __forceinline__ float sigmoidf_(float x) { return __builtin_amdgcn_rcpf(1.f + __expf(-x)); }
__device__ __forceinline__ float softplusf_(float x) { return fmaxf(x, 0.f) + __logf(1.f + __expf(-fabsf(x))); }

template <int TN>
__device__ __forceinline__ void gemm_mainloop(const int tidx, const bf16_t* __restrict__ A, int lda, const bf16_t* __restrict__ Bt, int ldb, int K,
                                              int m0, int n0, unsigned char* smem, f32x16 (&acc)[2][TN]) {
  const int tid = tidx, lane = tid & 63, wid = tid >> 6, wm = wid >> 1, wn = wid & 1;
  const int r = lane & 31, h = lane >> 5;
  const int lr0 = tid >> 2, lc = tid & 3;
  const bool bload = (TN == 2) || (tid < 256);
  const bf16_t* ga0 = A + (size_t)(m0 + lr0) * lda + lc * 8;
  const bf16_t* ga1 = ga0 + (size_t)128 * lda;
  const bf16_t* gb0 = Bt + (size_t)(n0 + (bload ? lr0 : 0)) * ldb + lc * 8;
  const int lw0 = lr0 * 80 + lc * 16, lw1 = lw0 + 128 * 80;
#pragma unroll
  for (int a = 0; a < 2; ++a)
#pragma unroll
    for (int b = 0; b < TN; ++b)
#pragma unroll
      for (int i = 0; i < 16; ++i) acc[a][b][i] = 0.f;
  uint4 ra0 = *(const uint4*)ga0, ra1 = *(const uint4*)ga1, rb0 = *(const uint4*)gb0;
  *(uint4*)(smem + lw0) = ra0; *(uint4*)(smem + lw1) = ra1;
  if (bload) *(uint4*)(smem + 20480 + lw0) = rb0;
  __syncthreads();
  const int nk = K >> 5;
  const int aoff = (wm * 64 + r) * 80 + h * 16, boff = 20480 + (wn * 32 * TN + r) * 80 + h * 16;
  for (int kt = 0; kt < nk; ++kt) {
    unsigned char* cur = smem + (kt & 1) * 30720;
    const bool more = (kt + 1 < nk);
    if (more) {
      const int ko = (kt + 1) * 32;
      ra0 = *(const uint4*)(ga0 + ko); ra1 = *(const uint4*)(ga1 + ko);
      rb0 = *(const uint4*)(gb0 + ko);
    }
    __builtin_amdgcn_sched_barrier(0);
    {
      bf16x8 fa0[2], fa1[2], fb0[2], fb1[2];
#pragma unroll
      for (int s = 0; s < 2; ++s) {
        fa0[s] = *(const bf16x8*)(cur + aoff + s * 32);
        fa1[s] = *(const bf16x8*)(cur + aoff + 32 * 80 + s * 32);
        fb0[s] = *(const bf16x8*)(cur + boff + s * 32);
        fb1[s] = fb0[s];
        if (TN == 2) fb1[s] = *(const bf16x8*)(cur + boff + 32 * 80 + s * 32);
      }
      __builtin_amdgcn_sched_barrier(0);
#pragma unroll
      for (int s = 0; s < 2; ++s) {
        acc[0][0] = __builtin_amdgcn_mfma_f32_32x32x16_bf16(fb0[s], fa0[s], acc[0][0], 0, 0, 0);
        acc[1][0] = __builtin_amdgcn_mfma_f32_32x32x16_bf16(fb0[s], fa1[s], acc[1][0], 0, 0, 0);
        if (TN == 2) {
          acc[0][TN - 1] = __builtin_amdgcn_mfma_f32_32x32x16_bf16(fb1[s], fa0[s], acc[0][TN - 1], 0, 0, 0);
          acc[1][TN - 1] = __builtin_amdgcn_mfma_f32_32x32x16_bf16(fb1[s], fa1[s], acc[1][TN - 1], 0, 0, 0);
        }
      }
    }
    __builtin_amdgcn_sched_barrier(0);
    if (more) {
      unsigned char* nxt = smem + ((kt + 1) & 1) * 30720;
      *(uint4*)(nxt + lw0) = ra0; *(uint4*)(nxt + lw1) = ra1;
      if (bload) *(uint4*)(nxt + 20480 + lw0) = rb0;
    }
    __syncthreads();
  }
}

#define EPI4(TN_, acc, m0, n0, ...)                                                                         \
  {                                                                                                         \
    const int _lane = tidx & 63, _wid = tidx >> 6, _wm = _wid >> 1, _wn = _wid & 1;                         \
    const int _r = _lane & 31, _h = _lane >> 5;                                                             \
    _Pragma("unroll") for (int _tm = 0; _tm < 2; ++_tm) _Pragma("unroll") for (int _tn = 0; _tn < TN_; ++_tn) \
    _Pragma("unroll") for (int _g = 0; _g < 4; ++_g) {                                                      \
      const int row = (m0) + _wm * 64 + _tm * 32 + _r;                                                      \
      const int col0 = (n0) + _wn * 32 * TN_ + _tn * 32 + 8 * _g + 4 * _h;                                  \
      const float v0 = acc[_tm][_tn][4 * _g], v1 = acc[_tm][_tn][4 * _g + 1], v2 = acc[_tm][_tn][4 * _g + 2], v3 = acc[_tm][_tn][4 * _g + 3]; \
      const float q0 = acc[_tm][_tn][(4 * _g) ^ 8], q1 = acc[_tm][_tn][(4 * _g + 1) ^ 8], q2 = acc[_tm][_tn][(4 * _g + 2) ^ 8], q3 = acc[_tm][_tn][(4 * _g + 3) ^ 8]; \
      (void)q0; (void)q1; (void)q2; (void)q3;                                                               \
      __VA_ARGS__                                                                                           \
    }                                                                                                       \
  }
__device__ __forceinline__ uint2 pack4(float a, float b, float c, float d) {
  uint2 o; o.x = (unsigned)f2bf(a) | ((unsigned)f2bf(b) << 16); o.y = (unsigned)f2bf(c) | ((unsigned)f2bf(d) << 16); return o;
}

template <int MAP>
__device__ __forceinline__ void cvt_job(const int tidx, const float* __restrict__ W, int ldw, int K, int Kp, int ncols, int col0, bf16_t* __restrict__ dst,
                                        float scale, float* tl, unsigned* ctr) {
  const int tx = tidx & 63, ty = tidx >> 6;
  const int nkt = Kp >> 6, nct = (ncols + 63) >> 6;
  volatile int* sbox = (volatile int*)(tl + 64 * 65);
  for (;;) {
    if (tidx == 0) *sbox = (int)atomicAdd(ctr, 1u);
    __syncthreads();
    const int tile = *sbox;
    if (tile >= nkt * nct) break;
    const int k0 = (tile % nkt) * 64, c0 = (tile / nkt) * 64;
#pragma unroll 4
    for (int kk = ty; kk < 64; kk += NW) {
      const int k = k0 + kk, col = c0 + tx;
      tl[kk * 65 + tx] = (k < K && col < ncols) ? W[(size_t)k * ldw + col0 + col] : 0.f;
    }
    __syncthreads();
#pragma unroll 4
    for (int nn = ty; nn < 64; nn += NW) {
      const int col = c0 + nn;
      if (col < ncols) {
        int drow = col;
        if (MAP == 1) { drow = (col < DFF) ? ((col >> 4) * 32 + (col & 15)) : (((col - DFF) >> 4) * 32 + 16 + ((col - DFF) & 15)); }
        dst[(size_t)drow * Kp + k0 + tx] = f2bf(tl[tx * 65 + nn] * scale);
      }
    }
    __syncthreads();
  }
}
__device__ __forceinline__ void zero_bf16(const int tidx, bf16_t* dst, size_t n) {
  for (size_t i = (size_t)blockIdx.x * NT + tidx; i < n; i += (size_t)gridDim.x * NT) dst[i] = 0;
}

__device__ __forceinline__ void convert_layer(const int tidx, const Params& p, int l, unsigned char* smem) {
  bf16_t* wb = (bf16_t*)(p.ws + ((l & 1) ? WS_WBF1 : WS_WBF));
  unsigned* cc = (unsigned*)(p.ws + WS_CTL) + 16384 + 64 * l;
  float* tl = (float*)smem;
  cvt_job<1>(tidx, p.in[I_F1IN] + (size_t)l * 1024 * 5632, 5632, 1024, 1024, 5632, 0, wb + WO_W1IN, 1.f, tl, cc + 0);
  cvt_job<0>(tidx, p.in[I_F1OUT] + (size_t)l * 2816 * 1024, 1024, 2816, 2816, 1024, 0, wb + WO_W1OUT, 1.f, tl, cc + 1);
  cvt_job<0>(tidx, p.in[I_MIXIN] + (size_t)l * 1024 * 6080, 6080, 1024, 1024, 3008, 0, wb + WO_WIN, 1.f, tl, cc + 2);
  zero_bf16(tidx, wb + WO_WIN + (size_t)3008 * 1024, (size_t)64 * 1024);
  cvt_job<0>(tidx, p.in[I_MIXIN] + (size_t)l * 1024 * 6080, 6080, 1024, 1024, 3072, 3008, wb + WO_WG, 1.f, tl, cc + 3);
  cvt_job<0>(tidx, p.in[I_W2] + (size_t)l * 64 * 384, 384, 64, 64, 384, 0, wb + WO_W2, 1.f, tl, cc + 4);
  cvt_job<0>(tidx, p.in[I_A2] + (size_t)l * 64 * 384, 384, 64, 64, 384, 0, wb + WO_A2, 1.f, tl, cc + 5);
  cvt_job<0>(tidx, p.in[I_G2] + (size_t)l * 160 * 384, 384, 160, 192, 384, 0, wb + WO_G2, 1.f, tl, cc + 6);
  cvt_job<0>(tidx, p.in[I_UQ] + (size_t)l * 256 * 576, 576, 256, 256, 576, 0, wb + WO_UQ, 0.10206207261596575f, tl, cc + 7);
  zero_bf16(tidx, wb + WO_UQ + (size_t)576 * 256, (size_t)64 * 256);
  cvt_job<0>(tidx, p.in[I_UKV] + (size_t)l * 128 * 768, 768, 128, 128, 768, 0, wb + WO_UKV, 1.f, tl, cc + 8);
  for (int n = 0; n < 3; ++n)
    cvt_job<0>(tidx, p.in[I_BW] + ((size_t)l * 3 + n) * 384 * 1024, 1024, 384, 384, 1024, 0, wb + WO_BW + (size_t)n * 1024 * 384, 1.f, tl, cc + 9 + n);
  cvt_job<0>(tidx, p.in[I_MIXOUT] + (size_t)l * 1024 * 1024, 1024, 1024, 1024, 1024, 0, wb + WO_WOUT, 1.f, tl, cc + 12);
  cvt_job<1>(tidx, p.in[I_F2IN] + (size_t)l * 1024 * 5632, 5632, 1024, 1024, 5632, 0, wb + WO_W2IN, 1.f, tl, cc + 13);
  cvt_job<0>(tidx, p.in[I_F2OUT] + (size_t)l * 2816 * 1024, 1024, 2816, 2816, 1024, 0, wb + WO_W2OUT, 1.f, tl, cc + 14);
}

__device__ __forceinline__ void phase_mod(const int tidx, const Params& p, unsigned char* smem) {
  float* modb = (float*)(p.ws + WS_MOD);
  float* cs = (float*)smem;
  const float* c = p.in[I_C];
  const int tid = tidx;
  for (int it = blockIdx.x; it < DEPTH * 18 * 8; it += gridDim.x) {
    const int kc = it & 7, cc = (it >> 3) % 18, l = it / (18 * 8);
    const int k0 = kc * 128;
    for (int e = tid; e < 2048; e += NT) {
      const int kk = e >> 4, b = e & 15;
      const float cv = c[b * 1024 + k0 + kk];
      cs[kk * 16 + b] = cv / (1.f + expf(-cv));
    }
    __syncthreads();
    const int col = cc * NT + tid;
    float acc[16];
#pragma unroll
    for (int b = 0; b < 16; ++b) acc[b] = 0.f;
    const float* w = p.in[I_ADAW] + ((size_t)l * 1024 + k0) * 9216 + col;
#pragma unroll 16
    for (int kk = 0; kk < 128; ++kk) {
      const float wv = w[(size_t)kk * 9216];
      const float4* cp = (const float4*)(cs + kk * 16);
      const float4 c0 = cp[0], c1 = cp[1], c2 = cp[2], c3 = cp[3];
      acc[0] += c0.x * wv; acc[1] += c0.y * wv; acc[2] += c0.z * wv; acc[3] += c0.w * wv;
      acc[4] += c1.x * wv; acc[5] += c1.y * wv; acc[6] += c1.z * wv; acc[7] += c1.w * wv;
      acc[8] += c2.x * wv; acc[9] += c2.y * wv; acc[10] += c2.z * wv; acc[11] += c2.w * wv;
      acc[12] += c3.x * wv; acc[13] += c3.y * wv; acc[14] += c3.z * wv; acc[15] += c3.w * wv;
    }
    const float bias = (kc == 0) ? p.in[I_ADAB][l * 9216 + col] : 0.f;
#pragma unroll
    for (int b = 0; b < 16; ++b) atomicAdd(&modb[((size_t)l * 16 + b) * 9216 + col], acc[b] + bias);
    __syncthreads();
  }
}
__device__ __forceinline__ void phase_rope(const int tidx, const Params& p) {
  float* rope = (float*)(p.ws + WS_ROPE);
  const int* pos = (const int*)p.in[I_POS];
  for (int e = blockIdx.x * NT + tidx; e < T * 16; e += gridDim.x * NT) {
    const int t = e >> 4, i = e & 15;
    const float invf = 1.0f / powf(10000.0f, (float)(2 * i) / 32.0f);
    const float ang = (float)pos[t] * invf;
    double x = (double)ang;
    x -= rint(x * 0.15915494309189535) * 6.283185307179586;
    const float xr = (float)x;
    rope[(size_t)t * 32 + i] = cosf(xr);
    rope[(size_t)t * 32 + 16 + i] = sinf(xr);
  }
}

__device__ __forceinline__ void phase_modnorm(const int tidx, const Params& p, int l, int sub, const float* xsrc) {
  bf16_t* H = (bf16_t*)(p.ws + WS_H);
  const float* modb = (const float*)(p.ws + WS_MOD) + (size_t)l * 16 * 9216;
  const float* g = p.in[I_NORMG] + ((size_t)l * 3 + sub) * 1024;
  const int lane = tidx & 63, wid = tidx >> 6;
  const int stride = gridDim.x * NW;
  int row = blockIdx.x * NW + wid;
  float4 v[4], vn[4];
  float4 gg[4];
#pragma unroll
  for (int q = 0; q < 4; ++q) { gg[q] = *(const float4*)(g + q * 256 + lane * 4); v[q] = *(const float4*)(xsrc + (size_t)row * 1024 + q * 256 + lane * 4); }
  for (; row < T; row += stride) {
    const int nrow = row + stride;
    if (nrow < T) {
#pragma unroll
      for (int q = 0; q < 4; ++q) vn[q] = *(const float4*)(xsrc + (size_t)nrow * 1024 + q * 256 + lane * 4);
    }
    const int b = row >> 11;
    const float* sh = modb + (size_t)b * 9216 + sub * 3072;
    const float* sc = sh + 1024;
    float ss = 0.f;
#pragma unroll
    for (int q = 0; q < 4; ++q) ss += v[q].x * v[q].x + v[q].y * v[q].y + v[q].z * v[q].z + v[q].w * v[q].w;
    ss = wave_sum(ss);
    const float rstd = rsqrtf(ss * (1.f / 1024.f) + 1e-6f);
#pragma unroll
    for (int q = 0; q < 4; ++q) {
      const int c0 = q * 256 + lane * 4;
      const float4 s4 = *(const float4*)(sc + c0), h4 = *(const float4*)(sh + c0);
      const float o0 = v[q].x * rstd * gg[q].x * (1.f + s4.x) + h4.x;
      const float o1 = v[q].y * rstd * gg[q].y * (1.f + s4.y) + h4.y;
      const float o2 = v[q].z * rstd * gg[q].z * (1.f + s4.z) + h4.z;
      const float o3 = v[q].w * rstd * gg[q].w * (1.f + s4.w) + h4.w;
      uint2 o;
      o.x = (unsigned)f2bf(o0) | ((unsigned)f2bf(o1) << 16);
      o.y = (unsigned)f2bf(o2) | ((unsigned)f2bf(o3) << 16);
      *(uint2*)(H + (size_t)row * 1024 + c0) = o;
    }
#pragma unroll
    for (int q = 0; q < 4; ++q) v[q] = vn[q];
  }
}

namespace pg8 {
#define PG8_LAS __attribute__((address_space(3)))
typedef float f32x4 __attribute__((ext_vector_type(4)));
typedef unsigned u32x4 __attribute__((ext_vector_type(4)));
constexpr int BM = 256, BK = 64, HALF = 128, HTB = HALF * BK * 2, NXCD = 8, WGM = 8;
__host__ __device__ __forceinline__ int lds_byte(int r, int c) { const int st = (r >> 4) * 2 + (c >> 5), rr = r & 15, cc = c & 31, ob = rr * 64 + cc * 2; return st * 1024 + (ob ^ (((ob >> 9) & 1) << 5)); }
__host__ __device__ __forceinline__ void stage_rc(int b, int& R, int& C) { const int st = b / 1024, sb = b % 1024, swz = sb ^ (((sb >> 9) & 1) << 5); R = (st >> 1) * 16 + swz / 64; C = (st & 1) * 32 + (swz % 64) / 2; }
__host__ __device__ __forceinline__ int perm32(int rho) { const int n = rho >> 4, i = rho & 15; return 8 * (i >> 2) + 4 * n + (i & 3); }
struct Unit { int pm, pn; };
struct Gemm { const bf16_t* A; const bf16_t* Bt; int M, N, K, lda, ldb; };
struct StaticOrder {
    int nM, nN, nwg, G, c;
    __host__ __device__ void init(int M, int N, int G_, int c_) { nM = M / BM; nN = N / BM; nwg = nM * nN; G = G_; c = c_; }
    __host__ __device__ bool next(int i, Unit& u) const {
        const long L = (long)i * G + c; if (L >= nwg) return false;
        int wgid = (int)L; { const int q = nwg / NXCD, r = nwg % NXCD, xcd = wgid % NXCD, off = wgid / NXCD; wgid = (xcd < r ? xcd * (q + 1) : r * (q + 1) + (xcd - r) * q) + off; }
        const int nig = WGM * nN, gid = wgid / nig, fm = gid * WGM, gsz = (nM - fm) < WGM ? (nM - fm) : WGM;
        u.pm = fm + ((wgid % nig) % gsz); u.pn = (wgid % nig) / gsz; return true;
    }
    __device__ __forceinline__ void a_ready(const Unit&) const {}
    __device__ __forceinline__ void done(const Unit&) const {}
};
__device__ __forceinline__ unsigned cvt_pk_bf16(float lo, float hi) { unsigned r; asm volatile("v_cvt_pk_bf16_f32 %0, %1, %2" : "=v"(r) : "v"(lo), "v"(hi)); return r; }
__device__ __forceinline__ float fsig(float x) { return __builtin_amdgcn_rcpf(1.f + __expf(-x)); }

struct EpiFfnIn {
    static constexpr bool PERM = true, AFTER_DRAIN = false;
    bf16_t* ACT;
    __device__ __forceinline__ void operator()(const f32x4 (&acc)[2][2][4][2], const Unit& u, int wr, int wc, int fr, int fq) const {
#pragma unroll
        for (int ai = 0; ai < 2; ++ai)
#pragma unroll
            for (int m = 0; m < 4; ++m) {
                const int row = u.pm * BM + ai * HALF + wr * 64 + m * 16 + fr;
#pragma unroll
                for (int bj = 0; bj < 2; ++bj) {
                    const int ocol = ((u.pn * BM + bj * HALF + wc * 32) >> 1) + 4 * fq;
                    const f32x4 g = acc[ai][bj][m][0], up = acc[ai][bj][m][1];
                    uint2 o;
                    o.x = cvt_pk_bf16(g[0] * fsig(g[0]) * up[0], g[1] * fsig(g[1]) * up[1]);
                    o.y = cvt_pk_bf16(g[2] * fsig(g[2]) * up[2], g[3] * fsig(g[3]) * up[3]);
                    *(uint2*)(ACT + (size_t)row * DFF + ocol) = o;
                }
            }
    }
};
struct EpiResid {
    static constexpr bool PERM = true, AFTER_DRAIN = false;
    const float* xsrc; float* xdst; const float* gate; float coef;
    __device__ __forceinline__ void operator()(const f32x4 (&acc)[2][2][4][2], const Unit& u, int wr, int wc, int fr, int fq) const {
        const float* gb = gate + (size_t)((u.pm * BM) >> 11) * 9216;
#pragma unroll
        for (int bj = 0; bj < 2; ++bj) {
            const int c0 = u.pn * BM + bj * HALF + wc * 32 + 8 * fq;
            const f32x4 g0 = *(const f32x4*)(gb + c0) * coef, g1 = *(const f32x4*)(gb + c0 + 4) * coef;
#pragma unroll
            for (int ai = 0; ai < 2; ++ai)
#pragma unroll
                for (int m = 0; m < 4; ++m) {
                    const int row = u.pm * BM + ai * HALF + wr * 64 + m * 16 + fr;
                    const size_t o = (size_t)row * 1024 + c0;
                    const f32x4 x0 = *(const f32x4*)(xsrc + o), x1 = *(const f32x4*)(xsrc + o + 4);
                    *(f32x4*)(xdst + o) = x0 + g0 * acc[ai][bj][m][0];
                    *(f32x4*)(xdst + o + 4) = x1 + g1 * acc[ai][bj][m][1];
                }
        }
    }
};
struct EpiMixIn {
    static constexpr bool PERM = true, AFTER_DRAIN = false;
    bf16_t* PRKV; float* PLORA; bf16_t* SBQKV; float* CQ;
    __device__ __forceinline__ void operator()(const f32x4 (&acc)[2][2][4][2], const Unit& u, int wr, int wc, int fr, int fq) const {
#pragma unroll
        for (int bj = 0; bj < 2; ++bj) {
            const int c0 = u.pn * BM + bj * HALF + wc * 32 + 8 * fq;
#pragma unroll
            for (int ai = 0; ai < 2; ++ai)
#pragma unroll
                for (int m = 0; m < 4; ++m) {
                    const int row = u.pm * BM + ai * HALF + wr * 64 + m * 16 + fr;
                    f32x4 v0 = acc[ai][bj][m][0], v1 = acc[ai][bj][m][1];
                    if (c0 < 1152) {
                        u32x4 w; w.x = cvt_pk_bf16(v0[0], v0[1]); w.y = cvt_pk_bf16(v0[2], v0[3]); w.z = cvt_pk_bf16(v1[0], v1[1]); w.w = cvt_pk_bf16(v1[2], v1[3]);
                        *(u32x4*)(PRKV + (size_t)row * 1152 + c0) = w;
                    } else if (c0 < 1440) {
                        float* d = PLORA + (size_t)row * 288 + (c0 - 1152);
                        *(f32x4*)d = v0; *(f32x4*)(d + 4) = v1;
                    } else if (c0 < 2592) {
                        const int c2 = c0 - 1440;
                        if (c2 < 384) { v0 = v0 * 0.125f; v1 = v1 * 0.125f; }
                        u32x4 w; w.x = cvt_pk_bf16(v0[0], v0[1]); w.y = cvt_pk_bf16(v0[2], v0[3]); w.z = cvt_pk_bf16(v1[0], v1[1]); w.w = cvt_pk_bf16(v1[2], v1[3]);
                        *(u32x4*)(SBQKV + (size_t)row * 1152 + c2) = w;
                    } else if (c0 < 3008) {
                        float* d = CQ + (size_t)row * 416 + (c0 - 2592);
                        *(f32x4*)d = v0; *(f32x4*)(d + 4) = v1;
                    }
                }
        }
    }
};
struct EpiGates {
    static constexpr bool PERM = true, AFTER_DRAIN = false;
    bf16_t* G;
    __device__ __forceinline__ void operator()(const f32x4 (&acc)[2][2][4][2], const Unit& u, int wr, int wc, int fr, int fq) const {
#pragma unroll
        for (int bj = 0; bj < 2; ++bj) {
            const int c0 = u.pn * BM + bj * HALF + wc * 32 + 8 * fq;
#pragma unroll
            for (int ai = 0; ai < 2; ++ai)
#pragma unroll
                for (int m = 0; m < 4; ++m) {
                    const int row = u.pm * BM + ai * HALF + wr * 64 + m * 16 + fr;
                    const f32x4 v0 = acc[ai][bj][m][0], v1 = acc[ai][bj][m][1];
                    u32x4 w; w.x = cvt_pk_bf16(fsig(v0[0]), fsig(v0[1])); w.y = cvt_pk_bf16(fsig(v0[2]), fsig(v0[3]));
                    w.z = cvt_pk_bf16(fsig(v1[0]), fsig(v1[1])); w.w = cvt_pk_bf16(fsig(v1[2]), fsig(v1[3]));
                    *(u32x4*)(G + (size_t)row * 3072 + c0) = w;
                }
        }
    }
};

struct EpiAll {
    static constexpr bool PERM = true, AFTER_DRAIN = false;
    int mode; EpiFfnIn e0; EpiResid e1; EpiMixIn e2; EpiGates e3;
    __device__ __forceinline__ void operator()(const f32x4 (&acc)[2][2][4][2], const Unit& u, int wr, int wc, int fr, int fq) const {
        if (mode == 0) e0(acc, u, wr, wc, fr, fq);
        else if (mode == 1) e1(acc, u, wr, wc, fr, fq);
        else if (mode == 2) e2(acc, u, wr, wc, fr, fq);
        else e3(acc, u, wr, wc, fr, fq);
    }
};

}

#define G256_DB 1
template <bool TR>
__device__ __forceinline__ void gemm256_tile(const int tidx, const bf16_t* __restrict__ A, int lda, const bf16_t* __restrict__ Bt, int ldb, int K,
                                             int m0, int n0, unsigned char* smem, f32x16 (&acc)[4][2]) {
  const int tid = tidx, lane = tid & 63, wid = tid >> 6, wm = wid >> 2, wn = wid & 3;
  const int r = lane & 31, h = lane >> 5;
  const int lr = tid >> 3, lc = tid & 7;
  const bf16_t* ga = A + (size_t)(m0 + lr) * lda + lc * 8;
  const bf16_t* gb = Bt + (size_t)(n0 + lr) * ldb + lc * 8;
  const size_t sa = (size_t)64 * lda, sb = (size_t)64 * ldb;
  const int lw = lr * 144 + lc * 16;
  const int aoff = (wm * 128 + r) * 144 + h * 16, boff = 36864 + (wn * 64 + r) * 144 + h * 16;
#pragma unroll
  for (int a = 0; a < 4; ++a)
#pragma unroll
    for (int b = 0; b < 2; ++b)
#pragma unroll
      for (int i = 0; i < 16; ++i) acc[a][b][i] = 0.f;
  uint4 Pa0, Pa1, Pa2, Pa3, Pb0, Pb1, Pb2, Pb3;
#define G256_LOAD(ko) { Pa0 = *(const uint4*)(ga + (ko)); Pa1 = *(const uint4*)(ga + sa + (ko)); Pa2 = *(const uint4*)(ga + 2 * sa + (ko)); Pa3 = *(const uint4*)(ga + 3 * sa + (ko)); \
                        Pb0 = *(const uint4*)(gb + (ko)); Pb1 = *(const uint4*)(gb + sb + (ko)); Pb2 = *(const uint4*)(gb + 2 * sb + (ko)); Pb3 = *(const uint4*)(gb + 3 * sb + (ko)); }
#define G256_STORE(st) { unsigned char* _d = smem + (st) * 73728 + lw; \
    *(uint4*)(_d) = Pa0; *(uint4*)(_d + 64 * 144) = Pa1; *(uint4*)(_d + 128 * 144) = Pa2; *(uint4*)(_d + 192 * 144) = Pa3; \
    *(uint4*)(_d + 36864) = Pb0; *(uint4*)(_d + 36864 + 64 * 144) = Pb1; *(uint4*)(_d + 36864 + 128 * 144) = Pb2; *(uint4*)(_d + 36864 + 192 * 144) = Pb3; }
  G256_LOAD(0)
  G256_STORE(0)
  __syncthreads();
  const int nk = K >> 6;
  for (int kt = 0; kt < nk; ++kt) {
    const bool more = (kt + 1 < nk);
    if (more) G256_LOAD((kt + 1) * 64)
    __builtin_amdgcn_sched_barrier(0);
    const unsigned char* cbuf = smem + (kt & 1) * 73728;
    bf16x8 fb[2][2], fa[2][4];
#define G256_FRAGS(d, s_) { fb[d][0] = *(const bf16x8*)(cbuf + boff + (s_) * 32); fb[d][1] = *(const bf16x8*)(cbuf + boff + 32 * 144 + (s_) * 32); \
      _Pragma("unroll") for (int tm = 0; tm < 4; ++tm) fa[d][tm] = *(const bf16x8*)(cbuf + aoff + tm * 32 * 144 + (s_) * 32); }
    if (G256_DB) G256_FRAGS(0, 0)
#pragma unroll
    for (int s = 0; s < 4; ++s) {
      if (G256_DB) { if (s < 3) G256_FRAGS((s + 1) & 1, s + 1) }
      else G256_FRAGS(0, s)
      __builtin_amdgcn_sched_barrier(0);
      __builtin_amdgcn_s_setprio(2);
#pragma unroll
      for (int tm = 0; tm < 4; ++tm) {
        if (TR) {
          acc[tm][0] = __builtin_amdgcn_mfma_f32_32x32x16_bf16(fb[s & 1][0], fa[s & 1][tm], acc[tm][0], 0, 0, 0);
          acc[tm][1] = __builtin_amdgcn_mfma_f32_32x32x16_bf16(fb[s & 1][1], fa[s & 1][tm], acc[tm][1], 0, 0, 0);
        } else {
          acc[tm][0] = __builtin_amdgcn_mfma_f32_32x32x16_bf16(fa[s & 1][tm], fb[s & 1][0], acc[tm][0], 0, 0, 0);
          acc[tm][1] = __builtin_amdgcn_mfma_f32_32x32x16_bf16(fa[s & 1][tm], fb[s & 1][1], acc[tm][1], 0, 0, 0);
        }
        if (more && s >= 1 && s <= 2) {
          __builtin_amdgcn_sched_barrier(0);
          unsigned char* _d = smem + ((kt + 1) & 1) * 73728 + lw;
          if (s == 1) {
            if (tm == 0) *(uint4*)(_d) = Pa0;
            if (tm == 1) *(uint4*)(_d + 64 * 144) = Pa1;
            if (tm == 2) *(uint4*)(_d + 128 * 144) = Pa2;
            if (tm == 3) *(uint4*)(_d + 192 * 144) = Pa3;
          } else {
            if (tm == 0) *(uint4*)(_d + 36864) = Pb0;
            if (tm == 1) *(uint4*)(_d + 36864 + 64 * 144) = Pb1;
            if (tm == 2) *(uint4*)(_d + 36864 + 128 * 144) = Pb2;
            if (tm == 3) *(uint4*)(_d + 36864 + 192 * 144) = Pb3;
          }
          __builtin_amdgcn_sched_barrier(0);
        }
      }
      __builtin_amdgcn_s_setprio(0);
      __builtin_amdgcn_sched_barrier(0);
    }
#undef G256_FRAGS
    __syncthreads();
  }
#undef G256_LOAD
#undef G256_STORE
}
#define EPI4G(acc, m0, n0, ...)                                                                             \
  {                                                                                                         \
    const int _lane = tidx & 63, _wid = tidx >> 6, _wm = _wid >> 2, _wn = _wid & 3;                         \
    const int _r = _lane & 31, _h = _lane >> 5;                                                             \
    _Pragma("unroll") for (int _tm = 0; _tm < 4; ++_tm) _Pragma("unroll") for (int _tn = 0; _tn < 2; ++_tn) \
    _Pragma("unroll") for (int _g = 0; _g < 4; ++_g) {                                                      \
      const int row = (m0) + _wm * 128 + _tm * 32 + _r;                                                     \
      const int col0 = (n0) + _wn * 64 + _tn * 32 + 8 * _g + 4 * _h;                                        \
      const float v0 = acc[_tm][_tn][4 * _g], v1 = acc[_tm][_tn][4 * _g + 1], v2 = acc[_tm][_tn][4 * _g + 2], v3 = acc[_tm][_tn][4 * _g + 3]; \
      __VA_ARGS__                                                                                           \
    }                                                                                                       \
  }
__device__ __forceinline__ float fsig(float x) { return __builtin_amdgcn_rcpf(1.f + __expf(-x)); }

__device__ __forceinline__ void phase_big_resid(const int tidx, const int vid, unsigned char* smem, const bf16_t* A, int ld, const bf16_t* Bt, int N, int K, const pg8::EpiAll& E) {
  const int wsc = __builtin_amdgcn_readfirstlane(tidx >> 6);
  const int nN = N / 256, nwg = (T / 256) * nN, nig = 8 * nN;
  pg8::Unit u;
  for (int L = vid; L < nwg; L += (int)gridDim.x) {
    { const int gid = L / nig, rem = L % nig; u.pm = gid * 8 + (rem & 7); u.pn = rem >> 3; }
    const int m0 = u.pm * 256, n0 = u.pn * 256;
    f32x16 acc[4][2];
    {
      gemm256_tile<false>(tidx, A, ld, Bt, ld, K, m0, n0, smem, acc);
      int tidr;
    asm volatile("v_mbcnt_lo_u32_b32 %0, -1, 0\n\tv_mbcnt_hi_u32_b32 %0, -1, %0\n\tv_lshl_add_u32 %0, %1, 6, %0" : "=&v"(tidr) : "s"(wsc));
      const float* gb = E.e1.gate + (size_t)(m0 >> 11) * 9216;
      const int _lane = tidr & 63, _wid = tidr >> 6, _wm = _wid >> 2, _wn = _wid & 3, _r = _lane & 31, _h = _lane >> 5;
#pragma unroll
      for (int tn = 0; tn < 2; ++tn) {
        const int col = n0 + _wn * 64 + tn * 32 + _r;
        const float gc = E.e1.coef * gb[col];
#pragma unroll
        for (int tm = 0; tm < 4; ++tm) {
          const float* xs = E.e1.xsrc + (size_t)(m0 + _wm * 128 + tm * 32 + 4 * _h) * 1024 + col;
          float* xd = E.e1.xdst + (size_t)(m0 + _wm * 128 + tm * 32 + 4 * _h) * 1024 + col;
#pragma unroll
          for (int hf = 0; hf < 2; ++hf) {
            float xv[8];
#pragma unroll
            for (int i = 0; i < 8; ++i) xv[i] = xs[((i & 3) + 8 * ((i + 8 * hf) >> 2)) * 1024];
#pragma unroll
            for (int i = 0; i < 8; ++i) xd[((i & 3) + 8 * ((i + 8 * hf) >> 2)) * 1024] = xv[i] + gc * acc[tm][tn][i + 8 * hf];
            asm volatile("" ::: "memory");
          }
        }
      }
    }
  }
}

__device__ __forceinline__ void phase_big(const int tidx, const int vid, unsigned char* smem, const bf16_t* A, int ld, const bf16_t* Bt, int N, int K, const pg8::EpiAll& E) {
  const int wsc = __builtin_amdgcn_readfirstlane(tidx >> 6);
  const int nN = N / 256, nwg = (T / 256) * nN, nig = 8 * nN;
  pg8::Unit u;
  for (int L = vid; L < nwg; L += (int)gridDim.x) {
    { const int gid = L / nig, rem = L % nig; u.pm = gid * 8 + (rem & 7); u.pn = rem >> 3; }
    const int m0 = u.pm * 256, n0 = u.pn * 256;
    f32x16 acc[4][2];
    gemm256_tile<true>(tidx, A, ld, Bt, ld, K, m0, n0, smem, acc);
    int tidr;
    asm volatile("v_mbcnt_lo_u32_b32 %0, -1, 0\n\tv_mbcnt_hi_u32_b32 %0, -1, %0\n\tv_lshl_add_u32 %0, %1, 6, %0" : "=&v"(tidr) : "s"(wsc));
    {
    const int tidx = tidr;
    if (E.mode == 0) {
      const int _lane = tidx & 63, _wid = tidx >> 6, _wm = _wid >> 2, _wn = _wid & 3, _r = _lane & 31, _h = _lane >> 5;
#pragma unroll
      for (int tm = 0; tm < 4; ++tm)
#pragma unroll
        for (int tn = 0; tn < 2; ++tn)
#pragma unroll
          for (int g = 0; g < 2; ++g) {
            const int row = m0 + _wm * 128 + tm * 32 + _r;
            const int hcol = ((n0 + _wn * 64 + tn * 32) >> 1) + 8 * g + 4 * _h;
            const float g0 = acc[tm][tn][4 * g], g1 = acc[tm][tn][4 * g + 1], g2 = acc[tm][tn][4 * g + 2], g3 = acc[tm][tn][4 * g + 3];
            const float u0 = acc[tm][tn][4 * g + 8], u1 = acc[tm][tn][4 * g + 9], u2 = acc[tm][tn][4 * g + 10], u3 = acc[tm][tn][4 * g + 11];
            *(uint2*)(E.e0.ACT + (size_t)row * DFF + hcol) = pack4(g0 * fsig(g0) * u0, g1 * fsig(g1) * u1, g2 * fsig(g2) * u2, g3 * fsig(g3) * u3);
          }
    } else if (E.mode == 2) {
      EPI4G(acc, m0, n0, {
        if (col0 < 1152) *(uint2*)(E.e2.PRKV + (size_t)row * 1152 + col0) = pack4(v0, v1, v2, v3);
        else if (col0 < 1440) { float4 o; o.x = v0; o.y = v1; o.z = v2; o.w = v3; *(float4*)(E.e2.PLORA + (size_t)row * 288 + (col0 - 1152)) = o; }
        else if (col0 < 2592) { const int c2 = col0 - 1440; const float sc = (c2 < 384) ? 0.125f : 1.f; *(uint2*)(E.e2.SBQKV + (size_t)row * 1152 + c2) = pack4(v0 * sc, v1 * sc, v2 * sc, v3 * sc); }
        else if (col0 < 3008) { float4 o; o.x = v0; o.y = v1; o.z = v2; o.w = v3; *(float4*)(E.e2.CQ + (size_t)row * 416 + (col0 - 2592)) = o; }
      })
    } else {
      EPI4G(acc, m0, n0, { *(uint2*)(E.e3.G + (size_t)row * 3072 + col0) = pack4(fsig(v0), fsig(v1), fsig(v2), fsig(v3)); })
    }
    }
  }
}

__device__ __forceinline__ void phase_prep(const int tidx, const Params& p, int l) {
  const float* PLORA = (const float*)(p.ws + WS_PLORA);
  const float* CQ = (const float*)(p.ws + WS_CQ);
  const float* rope = (const float*)(p.ws + WS_ROPE);
  bf16_t* LA = (bf16_t*)(p.ws + WS_LA);
  bf16_t* CQN = (bf16_t*)(p.ws + WS_CQN);
  bf16_t* KROPE = (bf16_t*)(p.ws + WS_KROPE);
  const float* mu = p.in[I_MU] + (size_t)l * 1440 + 1152;
  const float* qg = p.in[I_QNG] + (size_t)l * 256;
  const float* kvg = p.in[I_KVNG] + (size_t)l * 128;
  const int lane = tidx & 63, wid = tidx >> 6;
  for (int row = blockIdx.x * NW + wid; row < T; row += gridDim.x * NW) {
    const bool hasprev = (row & 2047) != 0;
#pragma unroll
    for (int q = 0; q < 5; ++q) {
      const int c = lane + 64 * q;
      float o = 0.f;
      if (c < 288) {
        const float cur = PLORA[(size_t)row * 288 + c];
        const float prev = hasprev ? PLORA[(size_t)(row - 1) * 288 + c] : 0.f;
        const float xs = cur + (prev - cur) * mu[c];
        o = (c < 64) ? tanhf(xs) : ((c < 128) ? xs : sigmoidf_(xs));
      }
      LA[(size_t)row * 320 + c] = f2bf(o);
    }
    float vq[4], vk[2];
    float ssq = 0.f, ssk = 0.f;
#pragma unroll
    for (int q = 0; q < 4; ++q) { vq[q] = CQ[(size_t)row * 416 + lane + 64 * q]; ssq += vq[q] * vq[q]; }
#pragma unroll
    for (int q = 0; q < 2; ++q) { vk[q] = CQ[(size_t)row * 416 + 256 + lane + 64 * q]; ssk += vk[q] * vk[q]; }
    ssq = wave_sum(ssq); ssk = wave_sum(ssk);
    const float rq = rsqrtf(ssq * (1.f / 256.f) + 1e-6f), rk = rsqrtf(ssk * (1.f / 128.f) + 1e-6f);
#pragma unroll
    for (int q = 0; q < 4; ++q) CQN[(size_t)row * 384 + lane + 64 * q] = f2bf(vq[q] * rq * qg[lane + 64 * q]);
#pragma unroll
    for (int q = 0; q < 2; ++q) CQN[(size_t)row * 384 + 256 + lane + 64 * q] = f2bf(vk[q] * rk * kvg[lane + 64 * q]);
    const float kr = (lane < 32) ? CQ[(size_t)row * 416 + 384 + lane] : 0.f;
    const float other = shflx(tidx, kr, 16);
    if (lane < 32) {
      const int i = lane & 15;
      const float cs = rope[(size_t)row * 32 + i], sn = rope[(size_t)row * 32 + 16 + i];
      const float o = (lane < 16) ? (kr * cs - other * sn) : (kr * cs + other * sn);
      KROPE[(size_t)row * 32 + lane] = f2bf(o);
    }
  }
}

__device__ __forceinline__ void phase_small_gemms(const int tidx, const Params& p, int l, unsigned char* smem) {
  const bf16_t* wb = (const bf16_t*)(p.ws + ((l & 1) ? WS_WBF1 : WS_WBF));
  const bf16_t* LA = (const bf16_t*)(p.ws + WS_LA);
  const bf16_t* CQN = (const bf16_t*)(p.ws + WS_CQN);
  const float* rope = (const float*)(p.ws + WS_ROPE);
  float* WL = (float*)(p.ws + WS_WL);
  float* AS = (float*)(p.ws + WS_AS);
  bf16_t* GG = (bf16_t*)(p.ws + WS_GG);
  bf16_t* MLAQ = (bf16_t*)(p.ws + WS_MLAQ);
  bf16_t* MLAKV = (bf16_t*)(p.ws + WS_MLAKV);
  const float* w0 = p.in[I_W0] + (size_t)l * 384;
  const float* a0 = p.in[I_A0] + (size_t)l * 384;
  for (int tile = blockIdx.x; tile < (T / 256) * 20; tile += gridDim.x) {
    const int pm = tile / 20, j = tile % 20, m0 = pm * 256;
    f32x16 acc[2][2];
    if (j < 3) {
      const int n0 = j * 128;
      gemm_mainloop<2>(tidx, LA, 320, wb + WO_W2, 64, 64, m0, n0, smem, acc);
      EPI4(2, acc, m0, n0, {
        const float4 w4 = *(const float4*)(w0 + col0);
        float4 o;
        o.x = -__expf(-softplusf_(-(w4.x + v0)) - 0.5f); o.y = -__expf(-softplusf_(-(w4.y + v1)) - 0.5f);
        o.z = -__expf(-softplusf_(-(w4.z + v2)) - 0.5f); o.w = -__expf(-softplusf_(-(w4.w + v3)) - 0.5f);
        *(float4*)(WL + (size_t)row * 384 + col0) = o;
      })
    } else if (j < 6) {
      const int n0 = (j - 3) * 128;
      gemm_mainloop<2>(tidx, LA + 64, 320, wb + WO_A2, 64, 64, m0, n0, smem, acc);
      EPI4(2, acc, m0, n0, {
        const float4 a4 = *(const float4*)(a0 + col0);
        float4 o;
        o.x = sigmoidf_(a4.x + v0); o.y = sigmoidf_(a4.y + v1); o.z = sigmoidf_(a4.z + v2); o.w = sigmoidf_(a4.w + v3);
        *(float4*)(AS + (size_t)row * 384 + col0) = o;
      })
    } else if (j < 9) {
      const int n0 = (j - 6) * 128;
      gemm_mainloop<2>(tidx, LA + 128, 320, wb + WO_G2, 192, 192, m0, n0, smem, acc);
      EPI4(2, acc, m0, n0, { *(uint2*)(GG + (size_t)row * 384 + col0) = pack4(v0, v1, v2, v3); })
    } else if (j < 14) {
      const int n0 = (j - 9) * 128;
      gemm_mainloop<2>(tidx, CQN, 384, wb + WO_UQ, 256, 256, m0, n0, smem, acc);
      EPI4(2, acc, m0, n0, {
        const int cm = col0 % 96;
        float o0 = v0, o1 = v1, o2 = v2, o3 = v3;
        if (cm >= 64) {
          const int ii = (cm - 64) & 15;
          const float4 cs = *(const float4*)(rope + (size_t)row * 32 + ii), sn = *(const float4*)(rope + (size_t)row * 32 + 16 + ii);
          if (cm < 80) { o0 = v0 * cs.x - q0 * sn.x; o1 = v1 * cs.y - q1 * sn.y; o2 = v2 * cs.z - q2 * sn.z; o3 = v3 * cs.w - q3 * sn.w; }
          else { o0 = v0 * cs.x + q0 * sn.x; o1 = v1 * cs.y + q1 * sn.y; o2 = v2 * cs.z + q2 * sn.z; o3 = v3 * cs.w + q3 * sn.w; }
        }
        if (col0 < 576) *(uint2*)(MLAQ + (size_t)row * 576 + col0) = pack4(o0, o1, o2, o3);
      })
    } else {
      const int n0 = (j - 14) * 128;
      gemm_mainloop<2>(tidx, CQN + 256, 384, wb + WO_UKV, 128, 128, m0, n0, smem, acc);
      EPI4(2, acc, m0, n0, { *(uint2*)(MLAKV + (size_t)row * 768 + col0) = pack4(v0, v1, v2, v3); })
    }
  }
}

__device__ __forceinline__ void scan_item(const int tidx, const Params& p, int l, int b, int h, unsigned char* smem) {
  const bf16_t* PRKV = (const bf16_t*)(p.ws + WS_PRKV);
  const float* WL = (const float*)(p.ws + WS_WL);
  const float* AS = (const float*)(p.ws + WS_AS);
  const bf16_t* GG = (const bf16_t*)(p.ws + WS_GG);
  bf16_t* Y = (bf16_t*)(p.ws + WS_Y);
  float* sr = (float*)smem;
  float* sw = sr + 2048;
  float* sk = sw + 2048;
  float* sv = sk + 2048;
  float* sa = sv + 2048;
  float* sb = sa + 2048;
  float* sy = sb + 2048;
  float* sbon = sy + 2048;
  const int tid = tidx, lane = tid & 63, wid = tid >> 6;
  const int hc = h * 64 + lane;
  const float mur = p.in[I_MU][(size_t)l * 1440 + hc], muk = p.in[I_MU][(size_t)l * 1440 + 384 + hc], muv = p.in[I_MU][(size_t)l * 1440 + 768 + hc];
  const float kkc = p.in[I_KK][(size_t)l * 384 + hc], kac = p.in[I_KA][(size_t)l * 384 + hc], rkc = p.in[I_RK][(size_t)l * 384 + hc];
  const float lng = p.in[I_LNG][(size_t)l * 384 + hc], lnb = p.in[I_LNB][(size_t)l * 384 + hc];
  const int rp = (tid & 255) >> 3, g = tid & 7;
  typedef float f32x2 __attribute__((ext_vector_type(2)));
  f32x2 S2[8];
#pragma unroll
  for (int j = 0; j < 8; ++j) S2[j] = (f32x2){0.f, 0.f};
  unsigned short rr[4], rk[4], rv[4], rr1[4], rk1[4], rv1[4], rg[4], rgn[4];
  float rwl[4], ras[4];
#define SCAN_LOAD(t0_) {                                                                             \
    _Pragma("unroll") for (int q = 0; q < 4; ++q) {                                                  \
      const int t = (t0_) + wid * 4 + q;                                                             \
      const size_t row = (size_t)b * SEQ + t;                                                        \
      const bf16_t* pr = PRKV + row * 1152;                                                          \
      rr[q] = pr[hc]; rk[q] = pr[384 + hc]; rv[q] = pr[768 + hc];                                    \
      rr1[q] = 0; rk1[q] = 0; rv1[q] = 0;                                                            \
      if (t > 0) { rr1[q] = *(pr + hc - 1152); rk1[q] = *(pr + 384 + hc - 1152); rv1[q] = *(pr + 768 + hc - 1152); } \
      rwl[q] = WL[row * 384 + hc]; ras[q] = AS[row * 384 + hc]; rgn[q] = GG[row * 384 + hc];        \
    } }
  SCAN_LOAD(0)
  for (int t0 = 0; t0 < SEQ; t0 += 32) {
#pragma unroll
    for (int q = 0; q < 4; ++q) {
      const int tt = wid * 4 + q;
      float r = bf2f(rr[q]), k = bf2f(rk[q]), v = bf2f(rv[q]);
      const float r1 = bf2f(rr1[q]), k1 = bf2f(rk1[q]), v1 = bf2f(rv1[q]);
      r = r + (r1 - r) * mur; k = k + (k1 - k) * muk; v = v + (v1 - v) * muv;
      const float decay = __expf(rwl[q]);
      const float as = ras[q];
      const float kkr = k * kkc;
      const float ss = wave_sum(kkr * kkr);
      const float kk = kkr * rsqrtf(fmaxf(ss, 1e-24f));
      const float k2 = k * (1.f + (as - 1.f) * kac);
      const float bon = wave_sum(r * k2 * rkc);
      sr[tt * 64 + lane] = r; sw[tt * 64 + lane] = decay; sk[tt * 64 + lane] = k2; sv[tt * 64 + lane] = v;
      sa[tt * 64 + lane] = -kk; sb[tt * 64 + lane] = kk * as;
      if (lane == 0) sbon[tt] = bon;
      rg[q] = rgn[q];
    }
    __syncthreads();
    if (t0 + 32 < SEQ) SCAN_LOAD(t0 + 32)
    if (wid < 4) {
#pragma unroll 4
      for (int tt = 0; tt < 32; ++tt) {
        const float4* pa = (const float4*)(sa + tt * 64 + g * 8);
        const float4* pw = (const float4*)(sw + tt * 64 + g * 8);
        const float4* pb = (const float4*)(sb + tt * 64 + g * 8);
        const float4* pk = (const float4*)(sk + tt * 64 + g * 8);
        const float4* prr = (const float4*)(sr + tt * 64 + g * 8);
        const float2 vi = *(const float2*)(sv + tt * 64 + 2 * rp);
        float av[8], wv[8], bv[8], kv[8], rv8[8];
#pragma unroll
        for (int q = 0; q < 2; ++q) {
          const float4 a4 = pa[q], w4 = pw[q], b4 = pb[q], k4 = pk[q], r4 = prr[q];
          av[q * 4] = a4.x; av[q * 4 + 1] = a4.y; av[q * 4 + 2] = a4.z; av[q * 4 + 3] = a4.w;
          wv[q * 4] = w4.x; wv[q * 4 + 1] = w4.y; wv[q * 4 + 2] = w4.z; wv[q * 4 + 3] = w4.w;
          bv[q * 4] = b4.x; bv[q * 4 + 1] = b4.y; bv[q * 4 + 2] = b4.z; bv[q * 4 + 3] = b4.w;
          kv[q * 4] = k4.x; kv[q * 4 + 1] = k4.y; kv[q * 4 + 2] = k4.z; kv[q * 4 + 3] = k4.w;
          rv8[q * 4] = r4.x; rv8[q * 4 + 1] = r4.y; rv8[q * 4 + 2] = r4.z; rv8[q * 4 + 3] = r4.w;
        }
        f32x2 sp_a = S2[0] * av[0] + S2[1] * av[1], sp_b = S2[2] * av[2] + S2[3] * av[3], sp_c = S2[4] * av[4] + S2[5] * av[5], sp_d = S2[6] * av[6] + S2[7] * av[7];
        const f32x2 sp = (sp_a + sp_b) + (sp_c + sp_d);
        const float sap0 = sum8(sp.x), sap1 = sum8(sp.y);
        const f32x2 sap2 = (f32x2){sap0, sap1}, vi2 = (f32x2){vi.x, vi.y};
        f32x2 yp_a = (f32x2){0.f, 0.f}, yp_b = (f32x2){0.f, 0.f};
#pragma unroll
        for (int j = 0; j < 8; j += 2) {
          S2[j] = S2[j] * wv[j] + sap2 * bv[j] + vi2 * kv[j];
          S2[j + 1] = S2[j + 1] * wv[j + 1] + sap2 * bv[j + 1] + vi2 * kv[j + 1];
          yp_a += S2[j] * rv8[j];
          yp_b += S2[j + 1] * rv8[j + 1];
        }
        const f32x2 ypv = yp_a + yp_b;
        const float yp0 = sum8(ypv.x), yp1 = sum8(ypv.y);
        if (g == 0) *(float2*)(sy + tt * 64 + 2 * rp) = make_float2(yp0, yp1);
      }
    }
    __syncthreads();
#pragma unroll
    for (int q = 0; q < 4; ++q) {
      const int tt = wid * 4 + q, t = t0 + tt;
      const size_t row = (size_t)b * SEQ + t;
      const float y = sy[tt * 64 + lane];
      const float mean = wave_sum(y) * (1.f / 64.f);
      const float d = y - mean;
      const float var = wave_sum(d * d) * (1.f / 64.f);
      const float yn = d * rsqrtf(var + 64e-5f) * lng + lnb;
      const float gg = bf2f(rg[q]);
      const float o = (yn + sbon[tt] * sv[tt * 64 + lane]) * gg;
      Y[row * 1152 + hc] = f2bf(o);
    }
    __syncthreads();
  }
#undef SCAN_LOAD
}

__device__ __forceinline__ void sb_item(const int tidx, const Params& p, int b, int h, int qb, unsigned char* smem) {
  const bf16_t* QKV = (const bf16_t*)(p.ws + WS_SBQKV);
  bf16_t* Y = (bf16_t*)(p.ws + WS_Y);
  float* Ks = (float*)smem;
  float* Vs = Ks + 4096;
  const int tid = tidx;
  const int t = qb * NT + tid;
  const size_t rowq = (size_t)b * SEQ + t;
  float q[64], o[64];
#pragma unroll
  for (int d = 0; d < 64; d += 8) {
    const uint4 u = *(const uint4*)(QKV + rowq * 1152 + h * 64 + d);
    q[d] = __uint_as_float(u.x << 16); q[d + 1] = __uint_as_float(u.x & 0xffff0000u);
    q[d + 2] = __uint_as_float(u.y << 16); q[d + 3] = __uint_as_float(u.y & 0xffff0000u);
    q[d + 4] = __uint_as_float(u.z << 16); q[d + 5] = __uint_as_float(u.z & 0xffff0000u);
    q[d + 6] = __uint_as_float(u.w << 16); q[d + 7] = __uint_as_float(u.w & 0xffff0000u);
  }
#pragma unroll
  for (int d = 0; d < 64; ++d) o[d] = 0.f;
  float run = 0.f;
  for (int kt = qb * 8 + 7; kt >= 0; --kt) {
    {
      const int kr = tid >> 3, dc = (tid & 7) * 8;
      const bf16_t* src = QKV + ((size_t)b * SEQ + kt * 64 + kr) * 1152 + h * 64 + dc;
#pragma unroll
      for (int e = 0; e < 8; ++e) { Ks[kr * 64 + dc + e] = bf2f(src[384 + e]); Vs[kr * 64 + dc + e] = bf2f(src[768 + e]); }
    }
    __syncthreads();
    for (int sl = 63; sl >= 0; --sl) {
      const int s = kt * 64 + sl;
      if (s < t) {
        const float4* kp = (const float4*)(Ks + sl * 64);
        float z = 0.f;
#pragma unroll
        for (int d4 = 0; d4 < 16; ++d4) { const float4 k4 = kp[d4]; z += q[d4 * 4] * k4.x + q[d4 * 4 + 1] * k4.y + q[d4 * 4 + 2] * k4.z + q[d4 * 4 + 3] * k4.w; }
        const float ln = -softplusf_(z);
        const float w = expf(z + ln + run);
        run += ln;
        const float4* vp = (const float4*)(Vs + sl * 64);
#pragma unroll
        for (int d4 = 0; d4 < 16; ++d4) { const float4 v4 = vp[d4]; o[d4 * 4] += w * v4.x; o[d4 * 4 + 1] += w * v4.y; o[d4 * 4 + 2] += w * v4.z; o[d4 * 4 + 3] += w * v4.w; }
      }
    }
    const bool alive = (run > -120.f);
    int* flag = (int*)(smem + 40960);
    if (tid == 0) *flag = 0;
    __syncthreads();
    if (__builtin_amdgcn_ballot_w64(alive) != 0ull && (tid & 63) == 0) *flag = 1;
    __syncthreads();
    const int any = *flag;
    __syncthreads();
    if (!any) break;
  }
  __syncthreads();
#pragma unroll
  for (int d = 0; d < 64; d += 2) {
    *(unsigned*)(Y + rowq * 1152 + 384 + h * 64 + d) = (unsigned)f2bf(o[d]) | ((unsigned)f2bf(o[d + 1]) << 16);
  }
}

__device__ __forceinline__ void mla_item(const int tidx, const Params& p, int b, int h, int qb, unsigned char* smem) {
  const bf16_t* MQ = (const bf16_t*)(p.ws + WS_MLAQ);
  const bf16_t* MKV = (const bf16_t*)(p.ws + WS_MLAKV);
  const bf16_t* KR = (const bf16_t*)(p.ws + WS_KROPE);
  bf16_t* Y = (bf16_t*)(p.ws + WS_Y);
  float* Ks = (float*)smem;
  float* Vs = Ks + 64 * 96;
  const int tid = tidx;
  const int t = qb * NT + tid;
  const size_t rowq = (size_t)b * SEQ + t;
  unsigned qp[48];
  float o[64];
#pragma unroll
  for (int d = 0; d < 12; ++d) {
    const uint4 u = *(const uint4*)(MQ + rowq * 576 + h * 96 + d * 8);
    qp[d * 4] = u.x; qp[d * 4 + 1] = u.y; qp[d * 4 + 2] = u.z; qp[d * 4 + 3] = u.w;
  }
#pragma unroll
  for (int d = 0; d < 64; ++d) o[d] = 0.f;
  float m = -1e30f, lsum = 0.f;
  for (int kt = 0; kt <= qb * 8 + 7; ++kt) {
    {
      const int kr = tid >> 3, part = tid & 7;
      const size_t rk = (size_t)b * SEQ + kt * 64 + kr;
      const bf16_t* srck = MKV + rk * 768 + h * 128 + part * 8;
      const bf16_t* srcv = srck + 64;
#pragma unroll
      for (int e = 0; e < 8; ++e) { Ks[kr * 96 + part * 8 + e] = bf2f(srck[e]); Vs[kr * 64 + part * 8 + e] = bf2f(srcv[e]); }
      const bf16_t* srcr = KR + rk * 32 + part * 4;
#pragma unroll
      for (int e = 0; e < 4; ++e) Ks[kr * 96 + 64 + part * 4 + e] = bf2f(srcr[e]);
    }
    __syncthreads();
    for (int sl = 0; sl < 64; ++sl) {
      const int s = kt * 64 + sl;
      if (s <= t) {
        const float4* kp = (const float4*)(Ks + sl * 96);
        float z = 0.f;
#pragma unroll
        for (int d4 = 0; d4 < 24; ++d4) { const float4 k4 = kp[d4]; const unsigned qa = qp[d4 * 2], qb2 = qp[d4 * 2 + 1];
          z += __uint_as_float(qa << 16) * k4.x + __uint_as_float(qa & 0xffff0000u) * k4.y + __uint_as_float(qb2 << 16) * k4.z + __uint_as_float(qb2 & 0xffff0000u) * k4.w; }
        if (z > m) {
          const float sc = expf(m - z);
          lsum *= sc;
#pragma unroll
          for (int d = 0; d < 64; ++d) o[d] *= sc;
          m = z;
        }
        const float w = expf(z - m);
        lsum += w;
        const float4* vp = (const float4*)(Vs + sl * 64);
#pragma unroll
        for (int d4 = 0; d4 < 16; ++d4) { const float4 v4 = vp[d4]; o[d4 * 4] += w * v4.x; o[d4 * 4 + 1] += w * v4.y; o[d4 * 4 + 2] += w * v4.z; o[d4 * 4 + 3] += w * v4.w; }
      }
    }
    __syncthreads();
  }
  const float inv = 1.f / lsum;
#pragma unroll
  for (int d = 0; d < 64; d += 2) {
    *(unsigned*)(Y + rowq * 1152 + 768 + h * 64 + d) = (unsigned)f2bf(o[d] * inv) | ((unsigned)f2bf(o[d + 1] * inv) << 16);
  }
}

__device__ __forceinline__ void mla_mfma_item(const int tidx, const Params& p, int b, int h, int qb, unsigned char* smem) {
  const bf16_t* MQ = (const bf16_t*)(p.ws + WS_MLAQ);
  const bf16_t* MKV = (const bf16_t*)(p.ws + WS_MLAKV);
  const bf16_t* KR = (const bf16_t*)(p.ws + WS_KROPE);
  bf16_t* Y = (bf16_t*)(p.ws + WS_Y);
  const int tid = tidx, lane = tid & 63, wid = tid >> 6, r = lane & 31, hh = lane >> 5;
  const int qw0 = qb * 256 + wid * 32;
  const size_t rowq = (size_t)b * SEQ + qw0 + r;
  bf16x8 qf[6];
#pragma unroll
  for (int s = 0; s < 6; ++s) qf[s] = *(const bf16x8*)(MQ + rowq * 576 + h * 96 + s * 16 + 8 * hh);
  f32x16 o[2];
#pragma unroll
  for (int i = 0; i < 16; ++i) { o[0][i] = 0.f; o[1][i] = 0.f; }
  float m = -1e30f, l = 0.f;
  const int ntiles = 4 * (qb + 1);
  const int skey = tid >> 3, sdc = tid & 7, rkey = (tid & 255) >> 2, rdc = tid & 3;
  const bf16_t* gk = MKV + ((size_t)b * SEQ + skey) * 768 + h * 128 + sdc * 8;
  const bf16_t* gr = KR + ((size_t)b * SEQ + rkey) * 32 + rdc * 8;
  uint4 kn = *(const uint4*)gk, vv = *(const uint4*)(gk + 64), kr4 = make_uint4(0, 0, 0, 0);
  if (tid < 256) kr4 = *(const uint4*)gr;
#define MLA_STORE(bufi) {                                                                             \
    unsigned char* _b = smem + (bufi) * 22016;                                                        \
    *(uint4*)(_b + skey * 208 + sdc * 16) = kn;                                                       \
    if (tid < 256) *(uint4*)(_b + rkey * 208 + 128 + rdc * 16) = kr4;                                 \
    unsigned short* _vt = (unsigned short*)(_b + 13312) + skey;                                       \
    const int _d0 = sdc * 8;                                                                          \
    _vt[(_d0 + 0) * 68] = (unsigned short)(vv.x & 0xffffu); _vt[(_d0 + 1) * 68] = (unsigned short)(vv.x >> 16); \
    _vt[(_d0 + 2) * 68] = (unsigned short)(vv.y & 0xffffu); _vt[(_d0 + 3) * 68] = (unsigned short)(vv.y >> 16); \
    _vt[(_d0 + 4) * 68] = (unsigned short)(vv.z & 0xffffu); _vt[(_d0 + 5) * 68] = (unsigned short)(vv.z >> 16); \
    _vt[(_d0 + 6) * 68] = (unsigned short)(vv.w & 0xffffu); _vt[(_d0 + 7) * 68] = (unsigned short)(vv.w >> 16); }
  MLA_STORE(0)
  __syncthreads();
  for (int kt = 0; kt < ntiles; ++kt) {
    if (kt + 1 < ntiles) {
      const size_t ko = (size_t)(kt + 1) * 64;
      kn = *(const uint4*)(gk + ko * 768); vv = *(const uint4*)(gk + ko * 768 + 64);
      if (tid < 256) kr4 = *(const uint4*)(gr + ko * 32);
    }
    if (kt * 64 <= qw0 + 31) {
      const unsigned char* Ks = smem + (kt & 1) * 22016;
      const unsigned char* Vt = Ks + 13312;
      f32x16 st[2];
#pragma unroll
      for (int kb = 0; kb < 2; ++kb) {
#pragma unroll
        for (int i = 0; i < 16; ++i) st[kb][i] = 0.f;
#pragma unroll
        for (int s = 0; s < 6; ++s) {
          const bf16x8 a = *(const bf16x8*)(Ks + (kb * 32 + r) * 208 + s * 32 + hh * 16);
          st[kb] = __builtin_amdgcn_mfma_f32_32x32x16_bf16(a, qf[s], st[kb], 0, 0, 0);
        }
      }
      if (kt * 64 + 63 > qw0) {
        const int qpos = qw0 + r;
#pragma unroll
        for (int kb = 0; kb < 2; ++kb)
#pragma unroll
          for (int i = 0; i < 16; ++i) {
            const int kpos = kt * 64 + kb * 32 + (i & 3) + 8 * (i >> 2) + 4 * hh;
            if (kpos > qpos) st[kb][i] = -1e30f;
          }
      }
      float mx = -1e30f;
#pragma unroll
      for (int kb = 0; kb < 2; ++kb)
#pragma unroll
        for (int i = 0; i < 16; ++i) mx = fmaxf(mx, st[kb][i]);
      mx = fmaxf(mx, shflx(tidx, mx, 32));
      const float mnew = fmaxf(m, mx);
      const float sc = __expf(m - mnew);
      m = mnew;
      float psum = 0.f;
#pragma unroll
      for (int kb = 0; kb < 2; ++kb)
#pragma unroll
        for (int i = 0; i < 16; ++i) { const float pv = __expf(st[kb][i] - mnew); st[kb][i] = pv; psum += pv; }
      psum += shflx(tidx, psum, 32);
      l = l * sc + psum;
#pragma unroll
      for (int i = 0; i < 16; ++i) { o[0][i] *= sc; o[1][i] *= sc; }
#pragma unroll
      for (int kb = 0; kb < 2; ++kb)
#pragma unroll
        for (int s2 = 0; s2 < 2; ++s2) {
          union { unsigned u[4]; bf16x8 v; } pk;
#pragma unroll
          for (int j = 0; j < 4; ++j) pk.u[j] = (unsigned)f2bf(st[kb][8 * s2 + 2 * j]) | ((unsigned)f2bf(st[kb][8 * s2 + 2 * j + 1]) << 16);
#pragma unroll
          for (int db = 0; db < 2; ++db) {
            const unsigned char* vp = Vt + (db * 32 + r) * 136 + (kb * 32 + 16 * s2 + 4 * hh) * 2;
            union { uint2 q2[2]; bf16x8 v; } va;
            va.q2[0] = *(const uint2*)vp; va.q2[1] = *(const uint2*)(vp + 16);
            o[db] = __builtin_amdgcn_mfma_f32_32x32x16_bf16(va.v, pk.v, o[db], 0, 0, 0);
          }
        }
    }
    if (kt + 1 < ntiles) MLA_STORE((kt + 1) & 1)
    __syncthreads();
  }
#undef MLA_STORE
  const float inv = 1.f / l;
#pragma unroll
  for (int db = 0; db < 2; ++db)
#pragma unroll
    for (int g = 0; g < 4; ++g) {
      const int d0 = db * 32 + 8 * g + 4 * hh;
      *(uint2*)(Y + rowq * 1152 + 768 + h * 64 + d0) = pack4(o[db][4 * g] * inv, o[db][4 * g + 1] * inv, o[db][4 * g + 2] * inv, o[db][4 * g + 3] * inv);
    }
}

__device__ __forceinline__ void sb_mfma_item(const int tidx, const Params& p, int b, int h, int qb, unsigned char* smem) {
  const bf16_t* QKV = (const bf16_t*)(p.ws + WS_SBQKV);
  bf16_t* Y = (bf16_t*)(p.ws + WS_Y);
  const int tid = tidx, lane = tid & 63, wid = tid >> 6, r = lane & 31, hh = lane >> 5;
  const int qw0 = qb * 256 + wid * 32;
  const int tq = qw0 + r;
  const size_t rowq = (size_t)b * SEQ + tq;
  bf16x8 qf[4];
#pragma unroll
  for (int s = 0; s < 4; ++s) qf[s] = *(const bf16x8*)(QKV + rowq * 1152 + h * 64 + s * 16 + 8 * hh);
  f32x16 o[2];
#pragma unroll
  for (int i = 0; i < 16; ++i) { o[0][i] = 0.f; o[1][i] = 0.f; }
  float run = 0.f;
  int* fl = (int*)(smem + 36864);
  const int skey = tid >> 3, sdc = tid & 7;
  const int ktmax = 4 * qb + 3;
  const bf16_t* gk = QKV + ((size_t)b * SEQ + skey) * 1152 + 384 + h * 64 + sdc * 8;
  uint4 kn = *(const uint4*)(gk + (size_t)ktmax * 64 * 1152), vv = *(const uint4*)(gk + (size_t)ktmax * 64 * 1152 + 384);
#define SB_STORE(bufi) {                                                                              \
    unsigned char* _b = smem + (bufi) * 17920;                                                        \
    *(uint4*)(_b + skey * 144 + sdc * 16) = kn;                                                       \
    unsigned short* _vt = (unsigned short*)(_b + 9216) + skey;                                        \
    const int _d0 = sdc * 8;                                                                          \
    _vt[(_d0 + 0) * 68] = (unsigned short)(vv.x & 0xffffu); _vt[(_d0 + 1) * 68] = (unsigned short)(vv.x >> 16); \
    _vt[(_d0 + 2) * 68] = (unsigned short)(vv.y & 0xffffu); _vt[(_d0 + 3) * 68] = (unsigned short)(vv.y >> 16); \
    _vt[(_d0 + 4) * 68] = (unsigned short)(vv.z & 0xffffu); _vt[(_d0 + 5) * 68] = (unsigned short)(vv.z >> 16); \
    _vt[(_d0 + 6) * 68] = (unsigned short)(vv.w & 0xffffu); _vt[(_d0 + 7) * 68] = (unsigned short)(vv.w >> 16); }
  SB_STORE(ktmax & 1)
  __syncthreads();
  for (int kt = ktmax; kt >= 0; --kt) {
    if (kt > 0) { const size_t ko = (size_t)(kt - 1) * 64 * 1152; kn = *(const uint4*)(gk + ko); vv = *(const uint4*)(gk + ko + 384); }
    const bool walive = __builtin_amdgcn_ballot_w64(run > -120.f) != 0ull;
    if (walive && kt * 64 <= qw0 + 30) {
      const unsigned char* Ks = smem + (kt & 1) * 17920;
      const unsigned char* Vt = Ks + 9216;
      f32x16 st[2];
#pragma unroll
      for (int kb = 0; kb < 2; ++kb) {
#pragma unroll
        for (int i = 0; i < 16; ++i) st[kb][i] = 0.f;
#pragma unroll
        for (int s = 0; s < 4; ++s) {
          const bf16x8 a = *(const bf16x8*)(Ks + (kb * 32 + r) * 144 + s * 32 + hh * 16);
          st[kb] = __builtin_amdgcn_mfma_f32_32x32x16_bf16(a, qf[s], st[kb], 0, 0, 0);
        }
      }
      const bool diag = (kt * 64 + 63 >= qw0);
      float ln[2][16], G[8];
#pragma unroll
      for (int kb = 0; kb < 2; ++kb)
#pragma unroll
        for (int g = 0; g < 4; ++g) {
          float gs = 0.f;
#pragma unroll
          for (int j = 0; j < 4; ++j) {
            const int i = 4 * g + j;
            const float z = st[kb][i];
            float v = -(fmaxf(z, 0.f) + __logf(1.f + __expf(-fabsf(z))));
            if (diag) { const int kpos = kt * 64 + kb * 32 + 8 * g + 4 * hh + j; if (kpos >= tq) v = 0.f; }
            ln[kb][i] = v; gs += v;
          }
          G[kb * 4 + g] = gs;
        }
      float Gp[8];
#pragma unroll
      for (int q = 0; q < 8; ++q) Gp[q] = shflx(tidx, G[q], 32);
      float aft[8];
      {
        float acc_o = 0.f, acc_p = 0.f;
#pragma unroll
        for (int q = 7; q >= 0; --q) {
          aft[q] = acc_o + acc_p + (hh == 0 ? Gp[q] : 0.f);
          acc_o += G[q]; acc_p += Gp[q];
        }
#pragma unroll
        for (int kb = 0; kb < 2; ++kb)
#pragma unroll
          for (int g = 0; g < 4; ++g) {
            float a3 = run + aft[kb * 4 + g];
#pragma unroll
            for (int j = 3; j >= 0; --j) {
              const int i = 4 * g + j;
              const float z = st[kb][i], l1 = ln[kb][i];
              float w = __expf(z + l1 + a3);
              if (diag) { const int kpos = kt * 64 + kb * 32 + 8 * g + 4 * hh + j; if (kpos >= tq) w = 0.f; }
              st[kb][i] = w;
              a3 += l1;
            }
          }
        run += acc_o + acc_p;
      }
#pragma unroll
      for (int kb = 0; kb < 2; ++kb)
#pragma unroll
        for (int s2 = 0; s2 < 2; ++s2) {
          union { unsigned u[4]; bf16x8 v; } pk;
#pragma unroll
          for (int j = 0; j < 4; ++j) pk.u[j] = (unsigned)f2bf(st[kb][8 * s2 + 2 * j]) | ((unsigned)f2bf(st[kb][8 * s2 + 2 * j + 1]) << 16);
#pragma unroll
          for (int db = 0; db < 2; ++db) {
            const unsigned char* vp = Vt + (db * 32 + r) * 136 + (kb * 32 + 16 * s2 + 4 * hh) * 2;
            union { uint2 q2[2]; bf16x8 v; } va;
            va.q2[0] = *(const uint2*)vp; va.q2[1] = *(const uint2*)(vp + 16);
            o[db] = __builtin_amdgcn_mfma_f32_32x32x16_bf16(va.v, pk.v, o[db], 0, 0, 0);
          }
        }
    }
    if (kt > 0) SB_STORE((kt - 1) & 1)
    const bool walive2 = __builtin_amdgcn_ballot_w64(run > -120.f) != 0ull;
    if (lane == 0) fl[(kt & 1) * 8 + wid] = walive2 ? 1 : 0;
    __syncthreads();
    int any = 0;
#pragma unroll
    for (int q = 0; q < 8; ++q) any |= fl[(kt & 1) * 8 + q];
    if (!any) break;
  }
#undef SB_STORE
  __syncthreads();
#pragma unroll
  for (int db = 0; db < 2; ++db)
#pragma unroll
    for (int g = 0; g < 4; ++g) {
      const int d0 = db * 32 + 8 * g + 4 * hh;
      *(uint2*)(Y + rowq * 1152 + 384 + h * 64 + d0) = pack4(o[db][4 * g], o[db][4 * g + 1], o[db][4 * g + 2], o[db][4 * g + 3]);
    }
}

__device__ __forceinline__ void phase_mixers(const int tidx, const Params& p, int l, unsigned char* smem) {
  volatile int* s_item_p = (volatile int*)(smem + 147440);
  unsigned* ctr = (unsigned*)(p.ws + WS_CTL) + 64 * l;
  for (;;) {
    if (tidx == 0) *s_item_p = (int)atomicAdd(ctr, 1u);
    __syncthreads();
    const int it = *s_item_p;
    __syncthreads();
    if (it >= 96 + 768 + 768) break;
    if (it < 96) {
#ifndef NO_SCAN
      scan_item(tidx, p, l, it / 6, it % 6, smem);
#endif
    } else {
      const int j = it - 96;
      if (j < 768) { const int qb = 7 - j / 96, jj = j % 96; mla_mfma_item(tidx, p, jj / 6, jj % 6, qb, smem); }
      else { const int j2 = j - 768, qb = 7 - j2 / 96, jj = j2 % 96; sb_mfma_item(tidx, p, jj / 6, jj % 6, qb, smem); }
    }
    __syncthreads();
  }
}

__device__ __forceinline__ void phase_merge(const int tidx, const Params& p, int l, unsigned char* smem) {
  const bf16_t* wb = (const bf16_t*)(p.ws + ((l & 1) ? WS_WBF1 : WS_WBF));
  const bf16_t* Y = (const bf16_t*)(p.ws + WS_Y);
  const bf16_t* GT = (const bf16_t*)(p.ws + WS_GATES);
  bf16_t* MG = (bf16_t*)(p.ws + WS_MERGED);
  constexpr int NTN = 8;
  for (int tile = blockIdx.x; tile < (T / 256) * NTN; tile += gridDim.x) {
    const int pm = tile / NTN, pn = tile % NTN, m0 = pm * 256, n0 = pn * 128;
    f32x16 tot[2][2];
#pragma unroll
    for (int a = 0; a < 2; ++a)
#pragma unroll
      for (int b = 0; b < 2; ++b)
#pragma unroll
        for (int i = 0; i < 16; ++i) tot[a][b][i] = 0.f;
#pragma unroll 1
    for (int n = 0; n < 3; ++n) {
      f32x16 acc[2][2];
      const bf16_t* gp = GT + n * 1024;
      uint2 gv[2][2][4];
      {
        const int _lane = tidx & 63, _wid = tidx >> 6, _wm = _wid >> 1, _wn = _wid & 1, _r = _lane & 31, _h = _lane >> 5;
#pragma unroll
        for (int a = 0; a < 2; ++a)
#pragma unroll
          for (int b = 0; b < 2; ++b)
#pragma unroll
            for (int g = 0; g < 4; ++g)
              gv[a][b][g] = *(const uint2*)(gp + (size_t)(m0 + _wm * 64 + a * 32 + _r) * 3072 + (n0 + _wn * 64 + b * 32 + 8 * g + 4 * _h));
      }
      __builtin_amdgcn_sched_barrier(0);
      gemm_mainloop<2>(tidx, Y + n * 384, 1152, wb + WO_BW + (size_t)n * 1024 * 384, 384, 384, m0, n0, smem, acc);
      {
#pragma unroll
        for (int a = 0; a < 2; ++a)
#pragma unroll
          for (int b = 0; b < 2; ++b)
#pragma unroll
            for (int g = 0; g < 4; ++g) {
              const uint2 u = gv[a][b][g];
              tot[a][b][4 * g] += __uint_as_float(u.x << 16) * acc[a][b][4 * g];
              tot[a][b][4 * g + 1] += __uint_as_float(u.x & 0xffff0000u) * acc[a][b][4 * g + 1];
              tot[a][b][4 * g + 2] += __uint_as_float(u.y << 16) * acc[a][b][4 * g + 2];
              tot[a][b][4 * g + 3] += __uint_as_float(u.y & 0xffff0000u) * acc[a][b][4 * g + 3];
            }
      }
    }
    EPI4(2, tot, m0, n0, { *(uint2*)(MG + (size_t)row * 1024 + col0) = pack4(v0, v1, v2, v3); })
  }
}

__device__ __forceinline__ void phase_final(const int tidx, const Params& p) {
  const float* g = p.in[I_FING];
  float* X = p.out;
  const int lane = tidx & 63, wid = tidx >> 6;
  for (int row = blockIdx.x * NW + wid; row < T; row += gridDim.x * NW) {
    float* xr = X + (size_t)row * 1024;
    float4 v[4];
    float ss = 0.f;
#pragma unroll
    for (int q = 0; q < 4; ++q) {
      v[q] = *(const float4*)(xr + q * 256 + lane * 4);
      ss += v[q].x * v[q].x + v[q].y * v[q].y + v[q].z * v[q].z + v[q].w * v[q].w;
    }
    ss = wave_sum(ss);
    const float rstd = rsqrtf(ss * (1.f / 1024.f) + 1e-6f);
#pragma unroll
    for (int q = 0; q < 4; ++q) {
      const int c0 = q * 256 + lane * 4;
      const float4 gg = *(const float4*)(g + c0);
      float4 o;
      o.x = v[q].x * rstd * gg.x; o.y = v[q].y * rstd * gg.y; o.z = v[q].z * rstd * gg.z; o.w = v[q].w * rstd * gg.w;
      *(float4*)(xr + c0) = o;
    }
  }
}

__global__ void __launch_bounds__(NT, 2) mega(Params p) {
  extern __shared__ __attribute__((aligned(16))) unsigned char smem[];
#ifdef EXP_ZERO
  {
    const int t0 = hipThreadIdx_x;
    for (int i = t0; i < LDS_BYTES / 16; i += NT) ((uint4*)smem)[i] = make_uint4(0, 0, 0, 0);
    uint4* wz = (uint4*)(p.ws + WS_WBF);
    const size_t n16 = (WS_END - WS_WBF) / 16;
    for (size_t i = (size_t)hipBlockIdx_x * NT + t0; i < n16; i += (size_t)hipGridDim_x * NT) wz[i] = make_uint4(0, 0, 0, 0);
    __syncthreads();
  }
#endif
  const unsigned xcc = (unsigned)__builtin_amdgcn_s_getreg((3 << 11) | 20) & 0xFu;
  unsigned* xcnt = (unsigned*)(p.ws + WS_CTL) + 8192;
  if (hipThreadIdx_x == 0) ((volatile int*)smem)[0] = (int)__hip_atomic_fetch_add(xcnt + 32 * xcc, 1u, __ATOMIC_RELAXED, __HIP_MEMORY_SCOPE_AGENT);
  cg::this_grid().sync();
  if (hipThreadIdx_x == 0) {
    int base = 0;
    for (unsigned x = 0; x < xcc; ++x) base += (int)__hip_atomic_load(xcnt + 32 * x, __ATOMIC_RELAXED, __HIP_MEMORY_SCOPE_AGENT);
    ((volatile int*)smem)[0] += base;
  }
  __syncthreads();
  const int vid = __builtin_amdgcn_readfirstlane(((volatile int*)smem)[0]);
  __syncthreads();
  const int wave_id = __builtin_amdgcn_readfirstlane((int)hipThreadIdx_x >> 6);
  for (int ph = p.ph_lo; ph < p.ph_hi; ++ph) {
    int tidx;
    asm volatile("v_mbcnt_lo_u32_b32 %0, -1, 0\n\tv_mbcnt_hi_u32_b32 %0, -1, %0\n\tv_lshl_add_u32 %0, %1, 6, %0" : "=&v"(tidx) : "s"(wave_id));
    {
      unsigned long long wsv = (unsigned long long)p.ws;
      asm volatile("" : "+s"(wsv));
      p.ws = (unsigned char*)(__attribute__((address_space(1))) unsigned char*)wsv;
    }
    const bf16_t* wb0 = (const bf16_t*)(p.ws + WS_WBF);
    const float* modall = (const float*)(p.ws + WS_MOD);
    if (ph == 0) {
      phase_mod(tidx, p, smem);
      phase_rope(tidx, p);
      convert_layer(tidx, p, 0, smem);
    } else if (ph == NPH - 1) {
      phase_final(tidx, p);
    } else {
      const int l = (ph - 1) / NPH_LAYER, s = (ph - 1) % NPH_LAYER;
      const bf16_t* wb = (l & 1) ? (const bf16_t*)(p.ws + WS_WBF1) : wb0;
      const float* modl = modall + (size_t)l * 16 * 9216;
      const float* xcur = (l == 0 && s <= 2) ? p.in[I_X] : p.out;
      const bf16_t* Hb = (const bf16_t*)(p.ws + WS_H);
      pg8::EpiAll E;
      E.mode = -1;
      const bf16_t* gA = Hb; const bf16_t* gB = wb; int gld = 1024, gN = 1024, gK = 1024;
      bf16_t* ACTp = (bf16_t*)(p.ws + WS_ACT);
      E.e0.ACT = ACTp;
      E.e1.xsrc = p.out; E.e1.xdst = p.out; E.e1.gate = modl; E.e1.coef = 0.5f;
      E.e2.PRKV = (bf16_t*)(p.ws + WS_PRKV); E.e2.PLORA = (float*)(p.ws + WS_PLORA); E.e2.SBQKV = (bf16_t*)(p.ws + WS_SBQKV); E.e2.CQ = (float*)(p.ws + WS_CQ);
      E.e3.G = (bf16_t*)(p.ws + WS_GATES);
      switch (s) {
        case 0:
          phase_modnorm(tidx, p, l, 0, xcur);
          break;
        case 1: E.mode = 0; gB = wb + WO_W1IN; gN = 5632; break;
        case 2: E.mode = 1; E.e1.xsrc = xcur; E.e1.gate = modl + 0 * 3072 + 2048; gA = ACTp; gB = wb + WO_W1OUT; gld = DFF; gK = DFF; break;
        case 3: phase_modnorm(tidx, p, l, 1, p.out); break;
        case 4: E.mode = 2; gB = wb + WO_WIN; gN = 3072; break;
        case 5: phase_prep(tidx, p, l); break;
#ifndef NO_SMALL
        case 6: phase_small_gemms(tidx, p, l, smem); break;
#endif
#ifndef NO_MIX
        case 7:
          phase_mixers(tidx, p, l, smem);
          if (l + 1 < DEPTH) convert_layer(tidx, p, l + 1, smem);
          break;
#endif
        case 8: E.mode = 3; gB = wb + WO_WG; gN = 3072; break;
#ifndef NO_MERGE
        case 9: phase_merge(tidx, p, l, smem); break;
#endif
        case 10: E.mode = 1; E.e1.gate = modl + 1 * 3072 + 2048; E.e1.coef = 1.0f; gA = (const bf16_t*)(p.ws + WS_MERGED); gB = wb + WO_WOUT; break;
        case 11: phase_modnorm(tidx, p, l, 2, p.out); break;
        case 12: E.mode = 0; gB = wb + WO_W2IN; gN = 5632; break;
        case 13: E.mode = 1; E.e1.gate = modl + 2 * 3072 + 2048; gA = ACTp; gB = wb + WO_W2OUT; gld = DFF; gK = DFF; break;
      }
#ifndef NO_PG8
      if (E.mode == 1) phase_big_resid(tidx, vid, smem, gA, gld, gB, gN, gK, E);
      else if (E.mode >= 0) phase_big(tidx, vid, smem, gA, gld, gB, gN, gK, E);
#endif
    }
    if (ph + 1 < p.ph_hi) {
      unsigned* bar = (unsigned*)(p.ws + WS_CTL) + 1024 + 32 * ph;
      asm volatile("s_waitcnt vmcnt(0) lgkmcnt(0)" ::: "memory");
      __syncthreads();
      if (tidx == 0) {
        __builtin_amdgcn_fence(__ATOMIC_RELEASE, "agent");
        asm volatile("s_waitcnt vmcnt(0)" ::: "memory");
        __hip_atomic_fetch_add(bar, 1u, __ATOMIC_RELAXED, __HIP_MEMORY_SCOPE_AGENT);
        while (__hip_atomic_load(bar, __ATOMIC_RELAXED, __HIP_MEMORY_SCOPE_AGENT) < gridDim.x) __builtin_amdgcn_s_sleep(2);
        __builtin_amdgcn_fence(__ATOMIC_ACQUIRE, "agent");
        asm volatile("s_waitcnt vmcnt(0)" ::: "memory");
      }
      __syncthreads();
    }
  }
}

extern "C" void kernel_launch(void* const* d_in, const int* in_sizes, int n_in, void* d_out, int out_size,
                              void* d_ws, size_t ws_size, hipStream_t stream) {
  static int grid_blocks = 0;
  if (!grid_blocks) {
    int dev = 0, cus = 0, per_cu = 0;
    (void)hipGetDevice(&dev);
    (void)hipDeviceGetAttribute(&cus, hipDeviceAttributeMultiprocessorCount, dev);
    if (hipFuncSetAttribute((const void*)mega, hipFuncAttributeMaxDynamicSharedMemorySize, LDS_BYTES) != hipSuccess)
      fprintf(stderr, "hipFuncSetAttribute(max dynamic LDS) failed\n");
    (void)hipOccupancyMaxActiveBlocksPerMultiprocessor(&per_cu, mega, NT, LDS_BYTES);
    if (per_cu < 1) fprintf(stderr, "occupancy query says %d blocks/CU\n", per_cu);
    grid_blocks = cus;
    if (ws_size < WS_END) fprintf(stderr, "ws too small: %zu < %zu\n", ws_size, (size_t)WS_END);
    (void)hipGetLastError();
  }
  Params p;
  memset(&p, 0, sizeof p);
  for (int i = 0; i < 29; ++i) p.in[i] = (const float*)d_in[i];
  p.out = (float*)d_out;
  p.ws = (unsigned char*)d_ws;
  p.ph_lo = 0; p.ph_hi = NPH;
  (void)hipMemsetAsync(d_ws, 0, 4 * MiB, stream);
  void* args[] = {&p};
  hipError_t e = hipLaunchCooperativeKernel((void*)mega, dim3(grid_blocks), dim3(NT), args, LDS_BYTES, stream);
  if (e != hipSuccess) fprintf(stderr, "coop launch failed: %s\n", hipGetErrorString(e));
}
```
